# Optimizing an MI355X kernel written in HIP

```python
import math
import jax, jax.numpy as jnp
from jax import lax
import numpy as np

D_MODEL = 1024
BATCH = 4
SEQ = 4096
DEPTH = 1

S5_WIDTH = D_MODEL // 2
S5_GROUP = 16
S5_GROUPS = S5_WIDTH // S5_GROUP
S5_STATE = 64
ATTN_HEADS = 8
HEAD_DIM = 64
ATTN_WIDTH = ATTN_HEADS * HEAD_DIM
Q_BLOCK = 128
FFN_HIDDEN = int(math.ceil(8 * D_MODEL / 3 / 256)) * 256
N_ADA = 6
RMS_EPS = 1e-6
IN_SIZES = (S5_WIDTH, ATTN_WIDTH, ATTN_WIDTH, ATTN_WIDTH, D_MODEL, D_MODEL)
IN_SPLITS = tuple(int(s) for s in np.cumsum(IN_SIZES)[:-1])
IN_WIDTH = int(sum(IN_SIZES))

kernel_name = "hybrid_s5_stickbreaking_adaln_block"


def rmsnorm(x, g):
    xf = x.astype(jnp.float32)
    xf = xf * lax.rsqrt(jnp.mean(xf * xf, axis=-1, keepdims=True) + RMS_EPS)
    return (xf * g.astype(jnp.float32)).astype(x.dtype)


def modulate(h, shift, scale):
    return h * (1.0 + scale) + shift


def _linear_recurrence(e1, e2):
    a1, b1 = e1
    a2, b2 = e2
    return a2 * a1, a2 * b1 + b2


def s5_branch(u, lam_re, lam_im, log_dt, b_re, b_im, c_re, c_im, d_skip, w_glu, b_glu):
    bsz, seq, _ = u.shape
    uf = u.astype(jnp.float32).reshape(bsz, seq, S5_GROUPS, S5_GROUP)
    lam = lax.complex(lam_re.astype(jnp.float32), lam_im.astype(jnp.float32))
    dt = jnp.exp(log_dt.astype(jnp.float32))[:, None]
    lam_bar = jnp.exp(lam * dt)
    b = lax.complex(b_re.astype(jnp.float32), b_im.astype(jnp.float32))
    b_bar = ((lam_bar - 1.0) / lam)[..., None] * b
    bu = jnp.einsum('btgi,gpi->btgp', uf.astype(jnp.complex64), b_bar)
    a = jnp.broadcast_to(lam_bar, bu.shape)
    _, states = lax.associative_scan(_linear_recurrence, (a, bu), axis=1)
    cmat = lax.complex(c_re.astype(jnp.float32), c_im.astype(jnp.float32))
    y = jnp.einsum('btgp,gip->btgi', states, cmat).real + d_skip.astype(jnp.float32) * uf
    y = jax.nn.gelu(y.reshape(bsz, seq, S5_WIDTH))
    y = y * jax.nn.sigmoid(y @ w_glu.astype(jnp.float32) + b_glu.astype(jnp.float32))
    return y.astype(u.dtype)


def stick_breaking_attention(q, k, v):
    bsz, seq, _ = q.shape
    n_blocks = seq // Q_BLOCK
    scale = 1.0 / math.sqrt(HEAD_DIM)
    qh = q.astype(jnp.float32).reshape(bsz, n_blocks, Q_BLOCK, ATTN_HEADS, HEAD_DIM)
    qh = qh.transpose(1, 0, 3, 2, 4)
    kh = k.astype(jnp.float32).reshape(bsz, seq, ATTN_HEADS, HEAD_DIM).transpose(0, 2, 1, 3)
    vh = v.astype(jnp.float32).reshape(bsz, seq, ATTN_HEADS, HEAD_DIM).transpose(0, 2, 1, 3)
    starts = jnp.arange(n_blocks, dtype=jnp.int32) * Q_BLOCK
    key_pos = jnp.arange(seq, dtype=jnp.int32)[None, :]

    def one_block(args):
        qb, t0 = args
        z = jnp.einsum('bhqd,bhkd->bhqk', qb, kh) * scale
        q_pos = t0 + jnp.arange(Q_BLOCK, dtype=jnp.int32)[:, None]
        mask = key_pos < q_pos
        log_not = jnp.where(mask, jax.nn.log_sigmoid(-z), 0.0)
        suffix = lax.cumsum(log_not, axis=3, reverse=True) - log_not
        weights = jnp.where(mask, jnp.exp(jax.nn.log_sigmoid(z) + suffix), 0.0)
        return jnp.einsum('bhqk,bhkd->bhqd', weights, vh)

    out = lax.map(one_block, (qh, starts))
    out = out.transpose(1, 0, 3, 2, 4).reshape(bsz, seq, ATTN_WIDTH)
    return out.astype(q.dtype)


def setup_inputs(seed: int = 0) -> dict:
    key = jax.random.key(seed)
    ks = jax.random.split(key, 26)
    f32 = jnp.float32
    D, L, G, P, GS = D_MODEL, DEPTH, S5_GROUPS, S5_STATE, S5_GROUP

    def nrm(k, shape, s):
        return jax.random.normal(k, shape, f32) * s

    return {
        "x": nrm(ks[0], (BATCH, SEQ, D), 1.0),
        "c": nrm(ks[1], (BATCH, D), 1.0),
        "w_ada": nrm(ks[2], (L, D, N_ADA * D), 0.1 * D ** -0.5),
        "b_ada": nrm(ks[3], (L, N_ADA * D), 0.1),
        "norm1_g": 1.0 + nrm(ks[4], (L, D), 0.01),
        "w_in": nrm(ks[5], (L, D, IN_WIDTH), D ** -0.5),
        "lam_re": -0.5 + nrm(ks[6], (L, G, P), 0.01),
        "lam_im": jnp.pi * jnp.arange(P, dtype=f32)[None, None, :] + nrm(ks[7], (L, G, P), 0.01),
        "log_dt": jax.random.uniform(ks[8], (L, G), f32, math.log(1e-3), math.log(1e-1)),
        "b_re": nrm(ks[9], (L, G, P, GS), (2.0 * GS) ** -0.5),
        "b_im": nrm(ks[10], (L, G, P, GS), (2.0 * GS) ** -0.5),
        "c_re": nrm(ks[11], (L, G, GS, P), (2.0 * P) ** -0.5),
        "c_im": nrm(ks[12], (L, G, GS, P), (2.0 * P) ** -0.5),
        "d_skip": nrm(ks[13], (L, G, GS), 1.0),
        "w_glu": nrm(ks[14], (L, S5_WIDTH, S5_WIDTH), S5_WIDTH ** -0.5),
        "b_glu": nrm(ks[15], (L, S5_WIDTH), 0.02),
        "w_a": nrm(ks[16], (L, S5_WIDTH, D), S5_WIDTH ** -0.5),
        "w_b": nrm(ks[17], (L, ATTN_WIDTH, D), ATTN_WIDTH ** -0.5),
        "w_o": nrm(ks[18], (L, D, D), D ** -0.5),
        "norm2_g": 1.0 + nrm(ks[19], (L, D), 0.01),
        "w_ffn_gate": nrm(ks[20], (L, D, FFN_HIDDEN), D ** -0.5),
        "w_ffn_up": nrm(ks[21], (L, D, FFN_HIDDEN), D ** -0.5),
        "w_ffn_down": nrm(ks[22], (L, FFN_HIDDEN, D), FFN_HIDDEN ** -0.5),
        "norm_f_g": 1.0 + nrm(ks[23], (D,), 0.01),
    }


def reference(x, c, w_ada, b_ada, norm1_g, w_in, lam_re, lam_im, log_dt, b_re, b_im, c_re, c_im,
              d_skip, w_glu, b_glu, w_a, w_b, w_o, norm2_g, w_ffn_gate, w_ffn_up, w_ffn_down, norm_f_g):
    cond = jax.nn.silu(c)
    for l in range(DEPTH):
        mod = (cond @ w_ada[l] + b_ada[l])[:, None, :]
        sh1, sc1, g1, sh2, sc2, g2 = jnp.split(mod, N_ADA, axis=-1)

        h = modulate(rmsnorm(x, norm1_g[l]), sh1, sc1)
        proj = h @ w_in[l]
        u, q, k, v, gate_a, gate_b = jnp.split(proj, IN_SPLITS, axis=-1)
        y_a = s5_branch(u, lam_re[l], lam_im[l], log_dt[l], b_re[l], b_im[l], c_re[l], c_im[l],
                        d_skip[l], w_glu[l], b_glu[l]) @ w_a[l]
        y_b = stick_breaking_attention(q, k, v) @ w_b[l]
        merged = (jax.nn.sigmoid(gate_a) * y_a + jax.nn.sigmoid(gate_b) * y_b) @ w_o[l]
        x = x + g1 * merged

        h = modulate(rmsnorm(x, norm2_g[l]), sh2, sc2)
        ffn = (jax.nn.silu(h @ w_ffn_gate[l]) * (h @ w_ffn_up[l])) @ w_ffn_down[l]
        x = x + g2 * ffn
    return rmsnorm(x, norm_f_g)
```

```cpp
#include <hip/hip_runtime.h>
#include <hip/hip_cooperative_groups.h>
#include <cstdio>
#include <cstdint>
namespace cg = cooperative_groups;
namespace pg8 {
#define PG8_LAS __attribute__((address_space(3)))
typedef unsigned short bf16_t;
typedef short bf16x8 __attribute__((ext_vector_type(8)));
typedef float f32x4 __attribute__((ext_vector_type(4)));
typedef unsigned u32x4 __attribute__((ext_vector_type(4)));
constexpr int BM = 256, BK = 64, HALF = 128, HTB = HALF * BK * 2  , STAGE_BYTES = 8 * HTB, NXCD = 8, WGM = 8;

__host__ __device__ __forceinline__ int lds_byte(int r, int c) { const int st = (r >> 4) * 2 + (c >> 5), rr = r & 15, cc = c & 31, ob = rr * 64 + cc * 2; return st * 1024 + (ob ^ (((ob >> 9) & 1) << 5)); }
__host__ __device__ __forceinline__ void stage_rc(int b, int& R, int& C) { const int st = b / 1024, sb = b % 1024, swz = sb ^ (((sb >> 9) & 1) << 5); R = (st >> 1) * 16 + swz / 64; C = (st & 1) * 32 + (swz % 64) / 2; }
__host__ __device__ __forceinline__ int perm32(int rho) { const int n = rho >> 4, i = rho & 15; return 8 * (i >> 2) + 4 * n + (i & 3); }

struct Unit { int pm, pn; };
struct Gemm { const bf16_t* A; const bf16_t* Bt; int M, N, K; };

struct StaticOrder {
    int nM, nN, nwg, G, c;
    __host__ __device__ void init(int M, int N, int G_, int c_) { nM = M / BM; nN = N / BM; nwg = nM * nN; G = G_; c = c_; }
    __host__ __device__ bool next(int i, Unit& u) const {
        const long L = (long)i * G + c; if (L >= nwg) return false;
        int wgid = (int)L; { const int q = nwg / NXCD, r = nwg % NXCD, xcd = wgid % NXCD, off = wgid / NXCD; wgid = (xcd < r ? xcd * (q + 1) : r * (q + 1) + (xcd - r) * q) + off; }
        const int nig = WGM * nN, gid = wgid / nig, fm = gid * WGM, gsz = (nM - fm) < WGM ? (nM - fm) : WGM;
        u.pm = fm + ((wgid % nig) % gsz); u.pn = (wgid % nig) / gsz; return true;
    }
    __device__ __forceinline__ void a_ready(const Unit&) const {}
    __device__ __forceinline__ void done(const Unit&) const {}
};
__device__ __forceinline__ unsigned cvt_pk_bf16(float lo, float hi) { unsigned r; asm volatile("v_cvt_pk_bf16_f32 %0, %1, %2" : "=v"(r) : "v"(lo), "v"(hi)); return r; }
template <class Epi, class Sched, bool ALIGN_EPI = false, bool SP2 = false>
__device__ __forceinline__ void gemm_phase(PG8_LAS unsigned char* lds, const Gemm g, const Sched& S, const Epi& E) {
    const int tid = threadIdx.x, wid = __builtin_amdgcn_readfirstlane(tid >> 6), lane = tid & 63, wr = wid >> 2, wc = wid & 3, fr = lane & 15, fq = lane >> 4;
    const int K = g.K, nt = K / BK;
    unsigned voffA[2], voffB[2];
#pragma unroll
    for (int i = 0; i < 2; ++i) { int R, C; stage_rc(tid * 16 + i * 8192, R, C); const int Rb = Epi::PERM ? ((R & ~31) + perm32(R & 31)) : R;
        voffA[i] = (unsigned)(R * K + C) * 2u; voffB[i] = (unsigned)(Rb * K + C) * 2u; }
    const size_t kstep = (size_t)(BK * 2);
    const size_t hstep = (size_t)HALF * K * 2;
    const size_t tstep = 2 * hstep;
    const unsigned ldsw = (unsigned)wid * 1024u;
    const int aoff = lds_byte(wr * 64 + fr, fq * 8), boff = lds_byte(wc * 32 + fr, fq * 8);
#define PG8_SA(b, h) (((b) * 2 + (h)) * HTB)
#define PG8_SB(b, h) ((4 + (b) * 2 + (h)) * HTB)
#define PG8_STAGE(bufoff, gbase, voff) do { _Pragma("unroll") for (int _i = 0; _i < 2; ++_i) \
        __builtin_amdgcn_global_load_lds((const unsigned*)((const char*)(gbase) + (voff)[_i]), (PG8_LAS unsigned*)(lds + (bufoff) + ldsw + _i * 8192), 16, 0, 0); } while (0)
#define PG8_LDA(dst, b, h) do { _Pragma("unroll") for (int m = 0; m < 4; ++m) _Pragma("unroll") for (int k = 0; k < 2; ++k) dst[m][k] = *(const PG8_LAS bf16x8*)(lds + PG8_SA(b, h) + aoff + m * 2048 + k * 1024); } while (0)
#define PG8_LDB(dst, b, h) do { _Pragma("unroll") for (int n = 0; n < 2; ++n) _Pragma("unroll") for (int k = 0; k < 2; ++k) dst[n][k] = *(const PG8_LAS bf16x8*)(lds + PG8_SB(b, h) + boff + n * 2048 + k * 1024); } while (0)
#define PG8_MMA(ai, bj, At, Bt) do { __builtin_amdgcn_s_setprio(1); _Pragma("unroll") for (int m = 0; m < 4; ++m) _Pragma("unroll") for (int n = 0; n < 2; ++n) _Pragma("unroll") for (int k = 0; k < 2; ++k) \
        acc[ai][bj][m][n] = __builtin_amdgcn_mfma_f32_16x16x32_bf16(Bt[n][k], At[m][k], acc[ai][bj][m][n], 0, 0, 0); __builtin_amdgcn_s_setprio(0); } while (0)
#define PG8_WAIT_V(n) asm volatile("s_waitcnt vmcnt(" #n ")" ::: "memory")
#define PG8_WAIT_L(n) asm volatile("s_waitcnt lgkmcnt(" #n ")" ::: "memory")
#define PG8_BAR __builtin_amdgcn_s_barrier()
#define PG8_SCHED __builtin_amdgcn_sched_barrier(0)
    Unit cur, nxt; int ui = 0;
    if (!S.next(0, cur)) return;
    f32x4 acc[2][2][4][2];
#pragma unroll
    for (int a = 0; a < 2; ++a)
#pragma unroll
        for (int b = 0; b < 2; ++b)
#pragma unroll
            for (int m = 0; m < 4; ++m)
#pragma unroll
                for (int n = 0; n < 2; ++n) acc[a][b][m][n] = (f32x4){0.f, 0.f, 0.f, 0.f};
    bf16x8 At[4][2], B0[2][2], B1[2][2];
    const char* cA = (const char*)g.A + (size_t)cur.pm * tstep; const char* cB = (const char*)g.Bt + (size_t)cur.pn * tstep;
    S.a_ready(cur);
    if constexpr (SP2) {
        PG8_STAGE(PG8_SB(0, 0), cB, voffB); PG8_STAGE(PG8_SB(0, 1), cB + hstep, voffB); PG8_STAGE(PG8_SA(0, 0), cA, voffA); PG8_STAGE(PG8_SA(0, 1), cA + hstep, voffA);
        if (wr == 1) PG8_BAR;
        PG8_WAIT_V(2); PG8_BAR;
        PG8_STAGE(PG8_SB(1, 0), cB + kstep, voffB); PG8_STAGE(PG8_SA(1, 0), cA + kstep, voffA); PG8_STAGE(PG8_SB(1, 1), cB + hstep + kstep, voffB);
        PG8_WAIT_V(6); PG8_BAR;
    } else {
        PG8_STAGE(PG8_SB(0, 0), cB, voffB); PG8_STAGE(PG8_SA(0, 0), cA, voffA); PG8_STAGE(PG8_SB(0, 1), cB + hstep, voffB); PG8_STAGE(PG8_SA(0, 1), cA + hstep, voffA);
        if (wr == 1) PG8_BAR;
        PG8_WAIT_V(4); PG8_BAR;
        PG8_STAGE(PG8_SB(1, 0), cB + kstep, voffB); PG8_STAGE(PG8_SA(1, 0), cA + kstep, voffA); PG8_STAGE(PG8_SB(1, 1), cB + hstep + kstep, voffB);
        PG8_WAIT_V(6); PG8_BAR;
    }
    for (;;) {
        const bool has_next = S.next(ui + 1, nxt);
        const char* nA = has_next ? (const char*)g.A + (size_t)nxt.pm * tstep : cA; const char* nB = has_next ? (const char*)g.Bt + (size_t)nxt.pn * tstep : cB;
        for (int t = 0; t < nt; t += 2) {
            const bool last = (t == nt - 2);
            const char* a1 = cA + (size_t)(t + 1) * kstep;
            const char* a2 = last ? nA : cA + (size_t)(t + 2) * kstep; const char* b2 = last ? nB : cB + (size_t)(t + 2) * kstep;
            const char* a3 = a2 + kstep; const char* b3 = b2 + kstep;
            if (last && has_next) S.a_ready(nxt);
            if constexpr (SP2) {
            PG8_LDB(B0, 0, 0); PG8_LDB(B1, 0, 1); PG8_SCHED; PG8_LDA(At, 0, 0); PG8_STAGE(PG8_SA(1, 1), a1 + hstep, voffA);
            PG8_WAIT_V(8); PG8_WAIT_L(0); PG8_BAR; PG8_MMA(0, 0, At, B0); PG8_MMA(0, 1, At, B1); PG8_BAR; PG8_SCHED;
            PG8_LDA(At, 0, 1); PG8_STAGE(PG8_SB(0, 0), b2, voffB); PG8_STAGE(PG8_SB(0, 1), b2 + hstep, voffB); PG8_STAGE(PG8_SA(0, 0), a2, voffA);
            PG8_WAIT_V(8); PG8_WAIT_L(0); PG8_BAR; PG8_MMA(1, 0, At, B0); PG8_MMA(1, 1, At, B1); PG8_BAR; PG8_SCHED;
            PG8_LDB(B0, 1, 0); PG8_LDB(B1, 1, 1); PG8_SCHED; PG8_LDA(At, 1, 0); PG8_STAGE(PG8_SA(0, 1), a2 + hstep, voffA);
            PG8_WAIT_V(8); PG8_WAIT_L(0); PG8_BAR; PG8_MMA(0, 0, At, B0); PG8_MMA(0, 1, At, B1); PG8_BAR; PG8_SCHED;
            PG8_LDA(At, 1, 1); PG8_STAGE(PG8_SB(1, 0), b3, voffB); PG8_STAGE(PG8_SB(1, 1), b3 + hstep, voffB); PG8_STAGE(PG8_SA(1, 0), a3, voffA);
            PG8_WAIT_V(8); PG8_WAIT_L(0); PG8_BAR; PG8_MMA(1, 0, At, B0); PG8_MMA(1, 1, At, B1); PG8_BAR; PG8_SCHED;
            } else {
            PG8_LDB(B0, 0, 0); PG8_SCHED; PG8_LDA(At, 0, 0); PG8_STAGE(PG8_SA(1, 1), a1 + hstep, voffA);
            PG8_WAIT_L(8); PG8_BAR; PG8_WAIT_L(0); PG8_MMA(0, 0, At, B0); PG8_BAR; PG8_SCHED;
            PG8_LDB(B1, 0, 1); PG8_STAGE(PG8_SB(0, 0), b2, voffB);
            PG8_BAR; PG8_WAIT_L(0); PG8_MMA(0, 1, At, B1); PG8_BAR;
            PG8_LDA(At, 0, 1); PG8_STAGE(PG8_SA(0, 0), a2, voffA);
            PG8_BAR; PG8_WAIT_L(0); PG8_MMA(1, 0, At, B0); PG8_BAR; PG8_SCHED;
            PG8_STAGE(PG8_SB(0, 1), b2 + hstep, voffB);
            PG8_WAIT_V(6); PG8_BAR; PG8_MMA(1, 1, At, B1); PG8_BAR;
            PG8_LDB(B0, 1, 0); PG8_SCHED; PG8_LDA(At, 1, 0); PG8_STAGE(PG8_SA(0, 1), a2 + hstep, voffA);
            PG8_WAIT_L(8); PG8_BAR; PG8_WAIT_L(0); PG8_MMA(0, 0, At, B0); PG8_BAR; PG8_SCHED;
            PG8_LDB(B1, 1, 1); PG8_STAGE(PG8_SB(1, 0), b3, voffB);
            PG8_BAR; PG8_WAIT_L(0); PG8_MMA(0, 1, At, B1); PG8_BAR;
            PG8_LDA(At, 1, 1); PG8_STAGE(PG8_SA(1, 0), a3, voffA);
            PG8_BAR; PG8_WAIT_L(0); PG8_MMA(1, 0, At, B0); PG8_BAR; PG8_SCHED;
            PG8_STAGE(PG8_SB(1, 1), b3 + hstep, voffB);
            PG8_WAIT_V(6); PG8_BAR; PG8_MMA(1, 1, At, B1); PG8_BAR;
            }
        }
        if constexpr (ALIGN_EPI) { if (wr == 0) PG8_BAR; }
        if constexpr (!Epi::AFTER_DRAIN) { E(acc, cur, wr, wc, fr, fq); S.done(cur); }
        if (!has_next) break;
#pragma unroll
        for (int a = 0; a < 2; ++a)
#pragma unroll
            for (int b = 0; b < 2; ++b)
#pragma unroll
                for (int m = 0; m < 4; ++m)
#pragma unroll
                    for (int n = 0; n < 2; ++n) acc[a][b][m][n] = (f32x4){0.f, 0.f, 0.f, 0.f};
        cur = nxt; cA = nA; cB = nB; ++ui;
        if constexpr (ALIGN_EPI) { if (wr == 1) PG8_BAR; }
    }
    PG8_WAIT_V(0);
    if constexpr (!ALIGN_EPI) { if (wr == 0) PG8_BAR; }
    PG8_BAR;
    if constexpr (Epi::AFTER_DRAIN) { E.fused(acc, cur, wr, wc, fr, fq, lds, wid, lane); S.done(cur); }
#undef PG8_SA
#undef PG8_SB
#undef PG8_STAGE
#undef PG8_LDA
#undef PG8_LDB
#undef PG8_MMA
#undef PG8_WAIT_V
#undef PG8_WAIT_L
#undef PG8_BAR
#undef PG8_SCHED
}
__device__ __forceinline__ float fsigmoid(float x) { return __builtin_amdgcn_rcpf(1.0f + __expf(-x)); }
__device__ __forceinline__ float bf_lo(unsigned w) { return __uint_as_float(w << 16); }
__device__ __forceinline__ float bf_hi(unsigned w) { return __uint_as_float(w & 0xffff0000u); }
__device__ __forceinline__ u32x4 pack8(const f32x4& v0, const f32x4& v1) { u32x4 w; w.x = cvt_pk_bf16(v0[0], v0[1]); w.y = cvt_pk_bf16(v0[2], v0[3]); w.z = cvt_pk_bf16(v1[0], v1[1]); w.w = cvt_pk_bf16(v1[2], v1[3]); return w; }
__device__ __forceinline__ void unpack8(const u32x4& w, f32x4& v0, f32x4& v1) { v0 = (f32x4){bf_lo(w.x), bf_hi(w.x), bf_lo(w.y), bf_hi(w.y)}; v1 = (f32x4){bf_lo(w.z), bf_hi(w.z), bf_lo(w.w), bf_hi(w.w)}; }

struct EpiProj { static constexpr bool PERM = true, AFTER_DRAIN = false; bf16_t* O;
    __device__ __forceinline__ void operator()(const f32x4 (&acc)[2][2][4][2], const Unit& u, int wr, int wc, int fr, int fq) const {
        const int row0 = u.pm * BM + wr * 64 + fr, col0 = u.pn * BM + wc * 32 + 8 * fq;
        const int mode = (u.pn >= 8) ? 2 : ((u.pn == 2 || u.pn == 3) ? 1 : 0);
#pragma unroll
        for (int ai = 0; ai < 2; ++ai)
#pragma unroll
            for (int m = 0; m < 4; ++m) { bf16_t* rowp = O + (size_t)(row0 + ai * HALF + m * 16) * 4096 + col0;
#pragma unroll
                for (int bj = 0; bj < 2; ++bj) { f32x4 v0 = acc[ai][bj][m][0], v1 = acc[ai][bj][m][1];
                    if (mode == 1) { v0 = v0 * 0.125f; v1 = v1 * 0.125f; }
                    else if (mode == 2) {
#pragma unroll
                        for (int j = 0; j < 4; ++j) { v0[j] = fsigmoid(v0[j]); v1[j] = fsigmoid(v1[j]); } }
                    *(u32x4*)(rowp + bj * HALF) = pack8(v0, v1); } }
    }
};
struct EpiGLU { static constexpr bool PERM = true, AFTER_DRAIN = false; const bf16_t* Y; bf16_t* O; const float* bias;
    __device__ __forceinline__ void operator()(const f32x4 (&acc)[2][2][4][2], const Unit& u, int wr, int wc, int fr, int fq) const {
        const int row0 = u.pm * BM + wr * 64 + fr, col0 = u.pn * BM + wc * 32 + 8 * fq;
#pragma unroll
        for (int ai = 0; ai < 2; ++ai)
#pragma unroll
            for (int m = 0; m < 4; ++m) { const size_t off = (size_t)(row0 + ai * HALF + m * 16) * 512 + col0;
#pragma unroll
                for (int bj = 0; bj < 2; ++bj) { const f32x4 b0 = *(const f32x4*)(bias + col0 + bj * HALF), b1 = *(const f32x4*)(bias + col0 + bj * HALF + 4);
                    f32x4 y0, y1; unpack8(*(const u32x4*)(Y + off + bj * HALF), y0, y1);
                    f32x4 v0 = acc[ai][bj][m][0] + b0, v1 = acc[ai][bj][m][1] + b1;
#pragma unroll
                    for (int j = 0; j < 4; ++j) { v0[j] = y0[j] * fsigmoid(v0[j]); v1[j] = y1[j] * fsigmoid(v1[j]); }
                    *(u32x4*)(O + off + bj * HALF) = pack8(v0, v1); } }
    }
};
template <bool ADD> struct EpiMerge { static constexpr bool PERM = true, AFTER_DRAIN = false; const bf16_t* Gt; bf16_t* O;
    __device__ __forceinline__ void operator()(const f32x4 (&acc)[2][2][4][2], const Unit& u, int wr, int wc, int fr, int fq) const {
        const int row0 = u.pm * BM + wr * 64 + fr, col0 = u.pn * BM + wc * 32 + 8 * fq;
#pragma unroll
        for (int ai = 0; ai < 2; ++ai)
#pragma unroll
            for (int m = 0; m < 4; ++m) { const size_t row = (size_t)(row0 + ai * HALF + m * 16);
#pragma unroll
                for (int bj = 0; bj < 2; ++bj) { f32x4 g0, g1; unpack8(*(const u32x4*)(Gt + row * 4096 + col0 + bj * HALF), g0, g1);
                    f32x4 v0 = acc[ai][bj][m][0] * g0, v1 = acc[ai][bj][m][1] * g1;
                    if (ADD) { f32x4 t0, t1; unpack8(*(const u32x4*)(O + row * 1024 + col0 + bj * HALF), t0, t1); v0 = v0 + t0; v1 = v1 + t1; }
                    *(u32x4*)(O + row * 1024 + col0 + bj * HALF) = pack8(v0, v1); } }
    }
};
struct EpiResid { static constexpr bool PERM = false, AFTER_DRAIN = false; const float* base; float* out; const float* gvec;
    __device__ __forceinline__ void operator()(const f32x4 (&acc)[2][2][4][2], const Unit& u, int wr, int wc, int fr, int fq) const {
        const int row0 = u.pm * BM + wr * 64 + fr, col0 = u.pn * BM + wc * 32 + 4 * fq;
        const float* gb = gvec + (size_t)(u.pm >> 4) * 6144;
        f32x4 gv[2][2];
#pragma unroll
        for (int bj = 0; bj < 2; ++bj)
#pragma unroll
            for (int n = 0; n < 2; ++n) gv[bj][n] = *(const f32x4*)(gb + col0 + bj * HALF + n * 16);
#pragma unroll
        for (int ai = 0; ai < 2; ++ai)
#pragma unroll
            for (int m = 0; m < 4; ++m) { const size_t off = (size_t)(row0 + ai * HALF + m * 16) * 1024 + col0;
#pragma unroll
                for (int bj = 0; bj < 2; ++bj)
#pragma unroll
                    for (int n = 0; n < 2; ++n) { const f32x4 b = *(const f32x4*)(base + off + bj * HALF + n * 16);
                        *(f32x4*)(out + off + bj * HALF + n * 16) = b + gv[bj][n] * acc[ai][bj][m][n]; } }
    }
};
struct EpiSwiGLU { static constexpr bool PERM = true, AFTER_DRAIN = false; bf16_t* O;
    __device__ __forceinline__ void operator()(const f32x4 (&acc)[2][2][4][2], const Unit& u, int wr, int wc, int fr, int fq) const {
        const int row0 = u.pm * BM + wr * 64 + fr, col0 = u.pn * HALF + wc * 32 + 8 * fq;
#pragma unroll
        for (int ai = 0; ai < 2; ++ai)
#pragma unroll
            for (int m = 0; m < 4; ++m) { f32x4 v0, v1;
#pragma unroll
                for (int j = 0; j < 4; ++j) { const float g0 = acc[ai][0][m][0][j], g1 = acc[ai][0][m][1][j];
                    v0[j] = g0 * fsigmoid(g0) * acc[ai][1][m][0][j]; v1[j] = g1 * fsigmoid(g1) * acc[ai][1][m][1][j]; }
                *(u32x4*)(O + (size_t)(row0 + ai * HALF + m * 16) * 2816 + col0) = pack8(v0, v1); }
    }
};
}

using pg8::bf16_t; using pg8::bf16x8; using pg8::f32x4; using pg8::u32x4;
#define LAS __attribute__((address_space(3)))
typedef float f32x16 __attribute__((ext_vector_type(16)));
constexpr int BATCH = 4, T = 4096, D = 1024, M = BATCH * T, NIN = 4096, FF = 2816, SG = 32, SP = 64, SW = 512, NCH = 64  ;
constexpr float RMS_EPS = 1e-6f;
constexpr float STICK_THETA = 40.0f;
constexpr size_t MiB = 1u << 20;
constexpr size_t WS_MOD = 0, WS_LBAR = 128 * 1024, WS_BBAR = 256 * 1024;
constexpr size_t WS_WIN = 1 * MiB, WS_WGLU = 9 * MiB, WS_WA = 10 * MiB, WS_WB = 11 * MiB, WS_WO = 12 * MiB, WS_WGU = 14 * MiB, WS_WD = 25 * MiB;
constexpr size_t WS_H = 32 * MiB;
constexpr size_t WS_PROJ = 64 * MiB;
constexpr size_t WS_ATTN = 192 * MiB, WS_YSSM = 208 * MiB, WS_S5OUT = 224 * MiB, WS_ENDS = 240 * MiB, WS_END = 244 * MiB;
constexpr int LDS_BYTES = 131072 + 1024;

struct Args {
    const float *x, *c, *w_ada, *b_ada, *norm1_g, *w_in, *lam_re, *lam_im, *log_dt, *b_re, *b_im, *c_re, *c_im, *d_skip, *w_glu, *b_glu, *w_a, *w_b, *w_o, *norm2_g, *w_gate, *w_up, *w_down, *norm_f_g;
    float* out; unsigned char* ws;
};

__device__ __forceinline__ unsigned f2bf(float f) { unsigned u = __float_as_uint(f); return (u + 0x7fffu + ((u >> 16) & 1u)) >> 16; }
__device__ __forceinline__ unsigned pk2(float lo, float hi) { return f2bf(lo) | (f2bf(hi) << 16); }
__device__ __forceinline__ float bf2f(unsigned short b) { return __uint_as_float(((unsigned)b) << 16); }
#define LDS_WAIT() asm volatile("s_waitcnt lgkmcnt(0)" ::: "memory")
__device__ __forceinline__ float wave_sum(float v) {
#pragma unroll
    for (int o = 1; o < 64; o <<= 1) v += __shfl_xor(v, o);
    return v;
}

__device__ __forceinline__ void transpose_item(const float* W, int K, int N, bf16_t* WT, int orow0, int k0, int n0, LAS float* scr, int lane) {
#pragma unroll 8
    for (int i = 0; i < 32; ++i) { const int kk = 2 * i + (lane >> 5); scr[kk * 33 + (lane & 31)] = W[(size_t)(k0 + kk) * N + n0 + (lane & 31)]; }
    LDS_WAIT();
    const int c = lane & 7;
#pragma unroll
    for (int j = 0; j < 4; ++j) { const int n = (lane >> 3) + 8 * j; const LAS float* s = scr + (8 * c) * 33 + n;
        u32x4 o; o.x = pk2(s[0 * 33], s[1 * 33]); o.y = pk2(s[2 * 33], s[3 * 33]); o.z = pk2(s[4 * 33], s[5 * 33]); o.w = pk2(s[6 * 33], s[7 * 33]);
        *(u32x4*)(WT + (size_t)(orow0 + n) * K + k0 + 8 * c) = o; }
    LDS_WAIT();
}
__device__ __forceinline__ void transpose_mat(const float* W, int K, int N, bf16_t* WT, int mode, int item, LAS float* scr, int lane) {
    const int nblk = N / 32, kb = item / nblk, nb = item % nblk, n0 = 32 * nb;
    const int orow0 = mode == 0 ? n0 : ((n0 >> 7) * 256 + (n0 & 127) + (mode == 2 ? 128 : 0));
    transpose_item(W, K, N, WT, orow0, 64 * kb, n0, scr, lane);
}

__device__ __forceinline__ bf16x8 pack_step8(float a0, float a1, float a2, float a3, float a4, float a5, float a6, float a7) {
    u32x4 p;
    asm volatile("v_cvt_pk_bf16_f32 %0, %4, %5\n\tv_cvt_pk_bf16_f32 %1, %6, %7\n\tv_cvt_pk_bf16_f32 %2, %8, %9\n\tv_cvt_pk_bf16_f32 %3, %10, %11\n\ts_nop 1"
                 : "=&v"(p[0]), "=&v"(p[1]), "=&v"(p[2]), "=&v"(p[3]) : "v"(a0), "v"(a1), "v"(a2), "v"(a3), "v"(a4), "v"(a5), "v"(a6), "v"(a7));
    return __builtin_bit_cast(bf16x8, p);
}
#define MFMA32(a, b, c) __builtin_amdgcn_mfma_f32_32x32x16_bf16((a), (b), (c), 0, 0, 0)
__device__ __forceinline__ void attn_item(const bf16_t* proj, bf16_t* attn, int item, int lane) {
    const int qt = item & 127, hd = (item >> 7) & 7, b = item >> 10;
    const int r = lane & 31, h = lane >> 5, q0 = qt * 32;
    const size_t rowbase = (size_t)b * T;
    bf16x8 qf[4];
    { const bf16_t* qp = proj + (rowbase + q0 + r) * NIN + 512 + hd * 64 + 8 * h;
#pragma unroll
      for (int s = 0; s < 4; ++s) qf[s] = *(const bf16x8*)(qp + 16 * s); }
    f32x16 o0, o1;
#pragma unroll
    for (int i = 0; i < 16; ++i) { o0[i] = 0.f; o1[i] = 0.f; }
    float R = 0.f;
    const int tq = q0 + r;
    for (int k0 = q0; k0 >= 0; k0 -= 32) {
        bf16x8 kf[4];
        { const bf16_t* kp = proj + (rowbase + k0 + r) * NIN + 1024 + hd * 64 + 8 * h;
#pragma unroll
          for (int s = 0; s < 4; ++s) kf[s] = *(const bf16x8*)(kp + 16 * s); }
        bf16x8 vf[2][2];
        { const bf16_t* vp = proj + (rowbase + k0 + 4 * h) * NIN + 1536 + hd * 64 + r;
#pragma unroll
          for (int mt = 0; mt < 2; ++mt)
#pragma unroll
            for (int s2 = 0; s2 < 2; ++s2)
#pragma unroll
              for (int j = 0; j < 8; ++j) vf[mt][s2][j] = (short)vp[(size_t)(16 * s2 + 8 * (j >> 2) + (j & 3)) * NIN + 32 * mt]; }
        f32x16 z;
#pragma unroll
        for (int i = 0; i < 16; ++i) z[i] = 0.f;
#pragma unroll
        for (int s = 0; s < 4; ++s) z = MFMA32(kf[s], qf[s], z);
        float sp[16], gs[4], og[4];
        const bool diag = (k0 == q0);
#pragma unroll
        for (int i = 0; i < 16; ++i) { const int key = k0 + (i & 3) + 8 * (i >> 2) + 4 * h; const float zz = z[i];
            const float s = fmaxf(zz, 0.f) + __logf(1.0f + __expf(-fabsf(zz)));
            sp[i] = (!diag || key < tq) ? s : 0.f; }
#pragma unroll
        for (int g = 0; g < 4; ++g) { gs[g] = (sp[4 * g] + sp[4 * g + 1]) + (sp[4 * g + 2] + sp[4 * g + 3]); og[g] = __shfl_xor(gs[g], 32); }
        float w[16]; float run = R;
#pragma unroll
        for (int g = 3; g >= 0; --g) { float a = run + (h == 0 ? og[g] : 0.f);
#pragma unroll
            for (int j = 3; j >= 0; --j) { const int i = 4 * g + j; const int key = k0 + j + 8 * g + 4 * h; a += sp[i];
                const float e = __expf(z[i] - a); w[i] = (!diag || key < tq) ? e : 0.f; }
            run += gs[g] + og[g]; }
        R = run;
        const bf16x8 w0 = pack_step8(w[0], w[1], w[2], w[3], w[4], w[5], w[6], w[7]);
        const bf16x8 w1 = pack_step8(w[8], w[9], w[10], w[11], w[12], w[13], w[14], w[15]);
        o0 = MFMA32(vf[0][0], w0, o0); o0 = MFMA32(vf[0][1], w1, o0);
        o1 = MFMA32(vf[1][0], w0, o1); o1 = MFMA32(vf[1][1], w1, o1);
        if (__all(R > STICK_THETA)) break;
    }
    bf16_t* op = attn + (rowbase + q0 + r) * SW + hd * 64 + 4 * h;
#pragma unroll
    for (int g = 0; g < 4; ++g) {
        uint2 a; a.x = pk2(o0[4 * g], o0[4 * g + 1]); a.y = pk2(o0[4 * g + 2], o0[4 * g + 3]); *(uint2*)(op + 8 * g) = a;
        uint2 c; c.x = pk2(o1[4 * g], o1[4 * g + 1]); c.y = pk2(o1[4 * g + 2], o1[4 * g + 3]); *(uint2*)(op + 32 + 8 * g) = c; }
}

__device__ __forceinline__ float gelu_tanh(float y) { const float t = 1.5957691216057308f * (y + 0.044715f * y * y * y); return y * __builtin_amdgcn_rcpf(1.0f + __expf(-t)); }
template <int PASS> __device__ __forceinline__ void s5_item(const Args& a, int item, LAS unsigned char* wl, int lane) {
    const int ch = item & 63, g = (item >> 6) & 31, b = item >> 11, gp = g * 64 + lane;
    const bf16_t* proj = (const bf16_t*)(a.ws + WS_PROJ);
    LAS float* ul = (LAS float*)wl;
    LAS unsigned short* Sl = (LAS unsigned short*)(wl + 4096);
    { const bf16_t* up = proj + ((size_t)(b * T + ch * 64 + lane)) * NIN + g * 16;
      const u32x4 a0 = *(const u32x4*)up, a1 = *(const u32x4*)(up + 8);
      f32x4 v0, v1, v2, v3; pg8::unpack8(a0, v0, v1); pg8::unpack8(a1, v2, v3);
      LAS f32x4* d = (LAS f32x4*)(ul + lane * 16); d[0] = v0; d[1] = v1; d[2] = v2; d[3] = v3; }
    const float* lb = (const float*)(a.ws + WS_LBAR);
    const float lr = lb[gp], li = lb[2048 + gp];
    float br[16], bi[16];
    { const f32x4* pr = (const f32x4*)((const float*)(a.ws + WS_BBAR) + (size_t)gp * 16); const f32x4* pi = (const f32x4*)((const float*)(a.ws + WS_BBAR) + 32768 + (size_t)gp * 16);
#pragma unroll
      for (int i = 0; i < 4; ++i) { const f32x4 x = pr[i], y = pi[i];
#pragma unroll
        for (int j = 0; j < 4; ++j) { br[4 * i + j] = x[j]; bi[4 * i + j] = y[j]; } } }
    float sr = 0.f, si = 0.f;
    float* ends_re = (float*)(a.ws + WS_ENDS); float* ends_im = ends_re + (size_t)BATCH * SG * NCH * SP;
    bf16x8 cf[4];
    f32x4 dsk;
    if (PASS == 1) {
        const float Lr = lb[4096 + gp], Li = lb[6144 + gp];
        const float* er = ends_re + ((size_t)(b * SG + g) * NCH) * SP + lane; const float* ei = ends_im + ((size_t)(b * SG + g) * NCH) * SP + lane;
        for (int c2 = 0; c2 < ch; ++c2) { const float xr = er[c2 * SP], xi = ei[c2 * SP]; const float nr = Lr * sr - Li * si + xr, ni = Lr * si + Li * sr + xi; sr = nr; si = ni; }
        const int i = lane & 15, fq = lane >> 4;
#pragma unroll
        for (int ks = 0; ks < 4; ++ks) { const float* src = (ks < 2 ? a.c_re : a.c_im) + ((size_t)(g * 16 + i)) * SP + 32 * (ks & 1) + 8 * fq;
            const f32x4 x0 = *(const f32x4*)src, x1 = *(const f32x4*)(src + 4); const float sg = ks < 2 ? 1.f : -1.f;
            u32x4 p; p.x = pk2(sg * x0[0], sg * x0[1]); p.y = pk2(sg * x0[2], sg * x0[3]); p.z = pk2(sg * x1[0], sg * x1[1]); p.w = pk2(sg * x1[2], sg * x1[3]);
            cf[ks] = __builtin_bit_cast(bf16x8, p); }
        dsk = *(const f32x4*)(a.d_skip + g * 16 + 4 * fq);
    }
    LDS_WAIT();
    for (int sub = 0; sub < 4; ++sub) {
#pragma unroll 4
        for (int tt = 0; tt < 16; ++tt) {
            const LAS f32x4* up4 = (const LAS f32x4*)(ul + (sub * 16 + tt) * 16);
            const f32x4 u0 = up4[0], u1 = up4[1], u2 = up4[2], u3 = up4[3];
            float bur = 0.f, bui = 0.f;
#pragma unroll
            for (int j = 0; j < 4; ++j) { bur += br[j] * u0[j]; bui += bi[j] * u0[j]; }
#pragma unroll
            for (int j = 0; j < 4; ++j) { bur += br[4 + j] * u1[j]; bui += bi[4 + j] * u1[j]; }
#pragma unroll
            for (int j = 0; j < 4; ++j) { bur += br[8 + j] * u2[j]; bui += bi[8 + j] * u2[j]; }
#pragma unroll
            for (int j = 0; j < 4; ++j) { bur += br[12 + j] * u3[j]; bui += bi[12 + j] * u3[j]; }
            const float nr = lr * sr - li * si + bur, ni = lr * si + li * sr + bui; sr = nr; si = ni;
            if (PASS == 1) { Sl[tt * 136 + lane] = (unsigned short)f2bf(sr); Sl[tt * 136 + 64 + lane] = (unsigned short)f2bf(si); }
        }
        if (PASS == 1) {
            LDS_WAIT();
            const int fr = lane & 15, fq = lane >> 4;
            f32x4 y = (f32x4){0.f, 0.f, 0.f, 0.f};
#pragma unroll
            for (int ks = 0; ks < 4; ++ks) { const bf16x8 af = *(const LAS bf16x8*)(Sl + fr * 136 + 32 * ks + 8 * fq);
                y = __builtin_amdgcn_mfma_f32_16x16x32_bf16(cf[ks], af, y, 0, 0, 0); }
            const f32x4 uu = *(const LAS f32x4*)(ul + (sub * 16 + fr) * 16 + 4 * fq);
            uint2 o; o.x = pk2(gelu_tanh(y[0] + dsk[0] * uu[0]), gelu_tanh(y[1] + dsk[1] * uu[1])); o.y = pk2(gelu_tanh(y[2] + dsk[2] * uu[2]), gelu_tanh(y[3] + dsk[3] * uu[3]));
            *(uint2*)((bf16_t*)(a.ws + WS_YSSM) + ((size_t)(b * T + ch * 64 + sub * 16 + fr)) * SW + g * 16 + 4 * fq) = o;
            LDS_WAIT();
        }
    }
    if (PASS == 0) { ends_re[(size_t)item * SP + lane] = sr; ends_im[(size_t)item * SP + lane] = si; }
}

__device__ __forceinline__ void norm_mod_row(const float* xrow, bf16_t* orow, const float* gn, const float* shift, const float* scale, int lane) {
    const f32x4* xr = (const f32x4*)xrow + lane; f32x4 v[4]; float s = 0.f;
#pragma unroll
    for (int j = 0; j < 4; ++j) { v[j] = xr[64 * j]; s += (v[j][0] * v[j][0] + v[j][1] * v[j][1]) + (v[j][2] * v[j][2] + v[j][3] * v[j][3]); }
    const float rstd = 1.0f / sqrtf(wave_sum(s) * (1.0f / D) + RMS_EPS);
    uint2* o8 = (uint2*)orow + lane;
#pragma unroll
    for (int j = 0; j < 4; ++j) { const f32x4 g = ((const f32x4*)gn)[lane + 64 * j], sh = ((const f32x4*)shift)[lane + 64 * j], sc = ((const f32x4*)scale)[lane + 64 * j];
        f32x4 hh;
#pragma unroll
        for (int k = 0; k < 4; ++k) hh[k] = v[j][k] * rstd * g[k] * (1.0f + sc[k]) + sh[k];
        uint2 w; w.x = pk2(hh[0], hh[1]); w.y = pk2(hh[2], hh[3]); o8[64 * j] = w; }
}
__device__ __forceinline__ void norm_final_row(float* row, const float* gn, int lane) {
    f32x4* xr = (f32x4*)row + lane; f32x4 v[4]; float s = 0.f;
#pragma unroll
    for (int j = 0; j < 4; ++j) { v[j] = xr[64 * j]; s += (v[j][0] * v[j][0] + v[j][1] * v[j][1]) + (v[j][2] * v[j][2] + v[j][3] * v[j][3]); }
    const float rstd = 1.0f / sqrtf(wave_sum(s) * (1.0f / D) + RMS_EPS);
#pragma unroll
    for (int j = 0; j < 4; ++j) { const f32x4 g = ((const f32x4*)gn)[lane + 64 * j]; xr[64 * j] = v[j] * rstd * g; }
}

__global__ void __launch_bounds__(512, 2) mega_fwd(Args a) {
    extern __shared__ __attribute__((aligned(16))) unsigned char lds_raw[];
    LAS unsigned char* lds = (LAS unsigned char*)lds_raw;
    cg::grid_group grid = cg::this_grid();
    const int tid = threadIdx.x, lane = tid & 63, wave = __builtin_amdgcn_readfirstlane(tid >> 6);
    const int Gd = gridDim.x, bx = blockIdx.x, gw = bx * 8 + wave, NGW = Gd * 8;
    unsigned char* ws = a.ws;
    float* mod = (float*)(ws + WS_MOD);
    bf16_t* Win_t = (bf16_t*)(ws + WS_WIN); bf16_t* Wglu_t = (bf16_t*)(ws + WS_WGLU); bf16_t* Wa_t = (bf16_t*)(ws + WS_WA); bf16_t* Wb_t = (bf16_t*)(ws + WS_WB);
    bf16_t* Wo_t = (bf16_t*)(ws + WS_WO); bf16_t* Wgu_t = (bf16_t*)(ws + WS_WGU); bf16_t* Wd_t = (bf16_t*)(ws + WS_WD);
    bf16_t* Hb = (bf16_t*)(ws + WS_H); bf16_t* proj = (bf16_t*)(ws + WS_PROJ); bf16_t* hidden = (bf16_t*)(ws + WS_PROJ);
    bf16_t* attn = (bf16_t*)(ws + WS_ATTN); bf16_t* yssm = (bf16_t*)(ws + WS_YSSM); bf16_t* s5out = (bf16_t*)(ws + WS_S5OUT);

    {
        LAS float* red = (LAS float*)lds;
        for (int it = bx; it < 96; it += Gd) {
            const int j = it * 64 + lane; float acc[4] = {0.f, 0.f, 0.f, 0.f};
            const float* wp = a.w_ada + (size_t)(wave * 128) * 6144 + j;
#pragma unroll 8
            for (int k = 0; k < 128; ++k) { const float wv = wp[(size_t)k * 6144];
#pragma unroll
                for (int bb = 0; bb < 4; ++bb) { const float cv = a.c[bb * D + wave * 128 + k]; acc[bb] += (cv * __builtin_amdgcn_rcpf(1.0f + __expf(-cv))) * wv; } }
#pragma unroll
            for (int bb = 0; bb < 4; ++bb) red[(wave * 4 + bb) * 64 + lane] = acc[bb];
            __syncthreads();
            if (tid < 256) { const int bb = tid >> 6; float s = a.b_ada[j];
#pragma unroll
                for (int w = 0; w < 8; ++w) s += red[(w * 4 + bb) * 64 + lane];
                mod[bb * 6144 + j] = s; }
            __syncthreads();
        }
        { const int gp = bx * 512 + tid;
          if (gp < SG * SP) { const int g = gp >> 6;
            const float dt = expf(a.log_dt[g]), lr = a.lam_re[gp], li = a.lam_im[gp], zr = lr * dt, zi = li * dt;
            const float em = expm1f(zr), cs = cosf(zi), sn = sinf(zi), sh = sinf(0.5f * zi);
            const float m1r = em * cs - 2.0f * sh * sh, m1i = (em + 1.0f) * sn;
            const float lbr = 1.0f + m1r, lbi = m1i;
            const float inv = 1.0f / (lr * lr + li * li);
            const float cr = (m1r * lr + m1i * li) * inv, ci = (m1i * lr - m1r * li) * inv;
            float pr = lbr, pi = lbi;
#pragma unroll
            for (int k = 0; k < 6; ++k) { const float nr = pr * pr - pi * pi, ni = 2.0f * pr * pi; pr = nr; pi = ni; }
            float* lb = (float*)(ws + WS_LBAR); lb[gp] = lbr; lb[2048 + gp] = lbi; lb[4096 + gp] = pr; lb[6144 + gp] = pi;
            float* bbr = (float*)(ws + WS_BBAR) + (size_t)gp * 16; float* bbi = (float*)(ws + WS_BBAR) + 32768 + (size_t)gp * 16;
#pragma unroll
            for (int i = 0; i < 16; ++i) { const float xr = a.b_re[(size_t)gp * 16 + i], xi = a.b_im[(size_t)gp * 16 + i]; bbr[i] = cr * xr - ci * xi; bbi[i] = cr * xi + ci * xr; } } }
        LAS float* scr = (LAS float*)(lds + wave * 16384);
        constexpr int I_IN = (D / 64) * (NIN / 32), I_GLU = (SW / 64) * (SW / 32), I_A = (SW / 64) * (D / 32), I_O = (D / 64) * (D / 32), I_G = (D / 64) * (FF / 32), I_D = (FF / 64) * (D / 32);
        constexpr int NITEMS = I_IN + I_GLU + 2 * I_A + I_O + 2 * I_G + I_D;
        for (int it = gw; it < NITEMS; it += NGW) {
            int r = it;
            if (r < I_IN) { transpose_mat(a.w_in, D, NIN, Win_t, 0, r, scr, lane); continue; } r -= I_IN;
            if (r < I_GLU) { transpose_mat(a.w_glu, SW, SW, Wglu_t, 0, r, scr, lane); continue; } r -= I_GLU;
            if (r < I_A) { transpose_mat(a.w_a, SW, D, Wa_t, 0, r, scr, lane); continue; } r -= I_A;
            if (r < I_A) { transpose_mat(a.w_b, SW, D, Wb_t, 0, r, scr, lane); continue; } r -= I_A;
            if (r < I_O) { transpose_mat(a.w_o, D, D, Wo_t, 0, r, scr, lane); continue; } r -= I_O;
            if (r < I_G) { transpose_mat(a.w_gate, D, FF, Wgu_t, 1, r, scr, lane); continue; } r -= I_G;
            if (r < I_G) { transpose_mat(a.w_up, D, FF, Wgu_t, 2, r, scr, lane); continue; } r -= I_G;
            transpose_mat(a.w_down, FF, D, Wd_t, 0, r, scr, lane);
        }
    }
    grid.sync();
    for (int m = gw; m < M; m += NGW) { const float* mb = mod + (size_t)(m >> 12) * 6144; norm_mod_row(a.x + (size_t)m * D, Hb + (size_t)m * D, a.norm1_g, mb, mb + 1024, lane); }
    grid.sync();
    { pg8::Gemm g{Hb, Win_t, M, NIN, D}; pg8::StaticOrder S; S.init(M, NIN, Gd, bx); pg8::EpiProj E{proj};
      pg8::gemm_phase<pg8::EpiProj, pg8::StaticOrder, true, true>(lds, g, S, E); }
    grid.sync();
    for (int it = gw; it < BATCH * 8 * (T / 32); it += NGW) attn_item(proj, attn, it, lane);
    for (int it = gw; it < BATCH * SG * NCH; it += NGW) s5_item<0>(a, it, lds + wave * 16384, lane);
    grid.sync();
    for (int it = gw; it < BATCH * SG * NCH; it += NGW) s5_item<1>(a, it, lds + wave * 16384, lane);
    grid.sync();
    { pg8::Gemm g{yssm, Wglu_t, M, SW, SW}; pg8::StaticOrder S; S.init(M, SW, Gd, bx); pg8::EpiGLU E{yssm, s5out, a.b_glu};
      pg8::gemm_phase<pg8::EpiGLU, pg8::StaticOrder, true, true>(lds, g, S, E); }
    grid.sync();
    { pg8::Gemm g{s5out, Wa_t, M, D, SW}; pg8::StaticOrder S; S.init(M, D, Gd, bx); pg8::EpiMerge<false> E{proj + 2048, Hb};
      pg8::gemm_phase<pg8::EpiMerge<false>, pg8::StaticOrder, true, true>(lds, g, S, E); }
    { pg8::Gemm g{attn, Wb_t, M, D, SW}; pg8::StaticOrder S; S.init(M, D, Gd, bx); pg8::EpiMerge<true> E{proj + 3072, Hb};
      pg8::gemm_phase<pg8::EpiMerge<true>, pg8::StaticOrder, true, true>(lds, g, S, E); }
    grid.sync();
    { pg8::Gemm g{Hb, Wo_t, M, D, D}; pg8::StaticOrder S; S.init(M, D, Gd, bx); pg8::EpiResid E{a.x, a.out, mod + 2 * 1024};
      pg8::gemm_phase<pg8::EpiResid, pg8::StaticOrder, true, true>(lds, g, S, E); }
    grid.sync();
    for (int m = gw; m < M; m += NGW) { const float* mb = mod + (size_t)(m >> 12) * 6144; norm_mod_row(a.out + (size_t)m * D, Hb + (size_t)m * D, a.norm2_g, mb + 3 * 1024, mb + 4 * 1024, lane); }
    grid.sync();
    { pg8::Gemm g{Hb, Wgu_t, M, 2 * FF, D}; pg8::StaticOrder S; S.init(M, 2 * FF, Gd, bx); pg8::EpiSwiGLU E{hidden};
      pg8::gemm_phase<pg8::EpiSwiGLU, pg8::StaticOrder, true, true>(lds, g, S, E); }
    grid.sync();
    { pg8::Gemm g{hidden, Wd_t, M, D, FF}; pg8::StaticOrder S; S.init(M, D, Gd, bx); pg8::EpiResid E{a.out, a.out, mod + 5 * 1024};
      pg8::gemm_phase<pg8::EpiResid, pg8::StaticOrder, true, true>(lds, g, S, E); }
    grid.sync();
    for (int m = gw; m < M; m += NGW) norm_final_row(a.out + (size_t)m * D, a.norm_f_g, lane);
}

extern "C" void kernel_launch(void* const* d_in, const int* in_sizes, int n_in, void* d_out, int out_size, void* d_ws, size_t ws_size, hipStream_t stream) {
    static int grid = 0;
    if (grid == 0) {
        if (n_in != 24 || ws_size < WS_END) { fprintf(stderr, "kernel_launch: unexpected inputs (n_in %d, ws %zu)\n", n_in, ws_size); grid = -1; return; }
        int dev = 0, cus = 0, per_cu = 0;
        hipGetDevice(&dev); hipDeviceGetAttribute(&cus, hipDeviceAttributeMultiprocessorCount, dev);
        if (hipFuncSetAttribute((const void*)mega_fwd, hipFuncAttributeMaxDynamicSharedMemorySize, LDS_BYTES) != hipSuccess) { fprintf(stderr, "kernel_launch: hipFuncSetAttribute failed\n"); grid = -1; return; }
        if (hipOccupancyMaxActiveBlocksPerMultiprocessor(&per_cu, (const void*)mega_fwd, 512, LDS_BYTES) != hipSuccess || per_cu < 1) { fprintf(stderr, "kernel_launch: occupancy query says %d\n", per_cu); per_cu = 1; }
        (void)hipGetLastError();
        grid = cus;
    }
    if (grid < 0) return;
    Args a{};
    const float** ap = (const float**)&a;
    for (int i = 0; i < 24; ++i) ap[i] = (const float*)d_in[i];
    a.out = (float*)d_out; a.ws = (unsigned char*)d_ws;
    void* args[] = {&a};
    hipError_t e = hipLaunchCooperativeKernel((const void*)mega_fwd, dim3(grid), dim3(512), args, LDS_BYTES, stream);
    if (e != hipSuccess) fprintf(stderr, "cooperative launch failed: %s (grid %d)\n", hipGetErrorString(e), grid);
}
```

```cpp
#include <hip/hip_runtime.h>
#include <hip/hip_cooperative_groups.h>
#include <cstdio>
#include <cstdint>
namespace cg = cooperative_groups;
namespace pg8 {
#define PG8_LAS __attribute__((address_space(3)))
typedef unsigned short bf16_t;
typedef short bf16x8 __attribute__((ext_vector_type(8)));
typedef float f32x4 __attribute__((ext_vector_type(4)));
typedef unsigned u32x4 __attribute__((ext_vector_type(4)));
constexpr int BM = 256, BK = 64, HALF = 128, HTB = HALF * BK * 2  , STAGE_BYTES = 8 * HTB, NXCD = 8, WGM = 8;

__host__ __device__ __forceinline__ int lds_byte(int r, int c) { const int st = (r >> 4) * 2 + (c >> 5), rr = r & 15, cc = c & 31, ob = rr * 64 + cc * 2; return st * 1024 + (ob ^ (((ob >> 9) & 1) << 5)); }
__host__ __device__ __forceinline__ void stage_rc(int b, int& R, int& C) { const int st = b / 1024, sb = b % 1024, swz = sb ^ (((sb >> 9) & 1) << 5); R = (st >> 1) * 16 + swz / 64; C = (st & 1) * 32 + (swz % 64) / 2; }
__host__ __device__ __forceinline__ int perm32(int rho) { const int n = rho >> 4, i = rho & 15; return 8 * (i >> 2) + 4 * n + (i & 3); }

struct Unit { int pm, pn; };
struct Gemm { const bf16_t* A; const bf16_t* Bt; int M, N, K; };

struct StaticOrder {
    int nM, nN, nwg, G, c;
    __host__ __device__ void init(int M, int N, int G_, int c_) { nM = M / BM; nN = N / BM; nwg = nM * nN; G = G_; c = c_; }
    __host__ __device__ bool next(int i, Unit& u) const {
        const long L = (long)i * G + c; if (L >= nwg) return false;
        int wgid = (int)L; { const int q = nwg / NXCD, r = nwg % NXCD, xcd = wgid % NXCD, off = wgid / NXCD; wgid = (xcd < r ? xcd * (q + 1) : r * (q + 1) + (xcd - r) * q) + off; }
        const int nig = WGM * nN, gid = wgid / nig, fm = gid * WGM, gsz = (nM - fm) < WGM ? (nM - fm) : WGM;
        u.pm = fm + ((wgid % nig) % gsz); u.pn = (wgid % nig) / gsz; return true;
    }
    __device__ __forceinline__ void a_ready(const Unit&) const {}
    __device__ __forceinline__ void done(const Unit&) const {}
};
__device__ __forceinline__ unsigned cvt_pk_bf16(float lo, float hi) { unsigned r; asm volatile("v_cvt_pk_bf16_f32 %0, %1, %2" : "=v"(r) : "v"(lo), "v"(hi)); return r; }
template <class Epi, class Sched, bool ALIGN_EPI = false, bool SP2 = false>
__device__ __forceinline__ void gemm_phase(PG8_LAS unsigned char* lds, const Gemm g, const Sched& S, const Epi& E) {
    const int tid = threadIdx.x, wid = __builtin_amdgcn_readfirstlane(tid >> 6), lane = tid & 63, wr = wid >> 2, wc = wid & 3, fr = lane & 15, fq = lane >> 4;
    const int K = g.K, nt = K / BK;
    unsigned voffA[2], voffB[2];
#pragma unroll
    for (int i = 0; i < 2; ++i) { int R, C; stage_rc(tid * 16 + i * 8192, R, C); const int Rb = Epi::PERM ? ((R & ~31) + perm32(R & 31)) : R;
        voffA[i] = (unsigned)(R * K + C) * 2u; voffB[i] = (unsigned)(Rb * K + C) * 2u; }
    const size_t kstep = (size_t)(BK * 2);
    const size_t hstep = (size_t)HALF * K * 2;
    const size_t tstep = 2 * hstep;
    const unsigned ldsw = (unsigned)wid * 1024u;
    const int aoff = lds_byte(wr * 64 + fr, fq * 8), boff = lds_byte(wc * 32 + fr, fq * 8);
#define PG8_SA(b, h) (((b) * 2 + (h)) * HTB)
#define PG8_SB(b, h) ((4 + (b) * 2 + (h)) * HTB)
#define PG8_STAGE(bufoff, gbase, voff) do { _Pragma("unroll") for (int _i = 0; _i < 2; ++_i) \
        __builtin_amdgcn_global_load_lds((const unsigned*)((const char*)(gbase) + (voff)[_i]), (PG8_LAS unsigned*)(lds + (bufoff) + ldsw + _i * 8192), 16, 0, 0); } while (0)
#define PG8_LDA(dst, b, h) do { _Pragma("unroll") for (int m = 0; m < 4; ++m) _Pragma("unroll") for (int k = 0; k < 2; ++k) dst[m][k] = *(const PG8_LAS bf16x8*)(lds + PG8_SA(b, h) + aoff + m * 2048 + k * 1024); } while (0)
#define PG8_LDB(dst, b, h) do { _Pragma("unroll") for (int n = 0; n < 2; ++n) _Pragma("unroll") for (int k = 0; k < 2; ++k) dst[n][k] = *(const PG8_LAS bf16x8*)(lds + PG8_SB(b, h) + boff + n * 2048 + k * 1024); } while (0)
#define PG8_MMA(ai, bj, At, Bt) do { __builtin_amdgcn_s_setprio(1); _Pragma("unroll") for (int m = 0; m < 4; ++m) _Pragma("unroll") for (int n = 0; n < 2; ++n) _Pragma("unroll") for (int k = 0; k < 2; ++k) \
        acc[ai][bj][m][n] = __builtin_amdgcn_mfma_f32_16x16x32_bf16(Bt[n][k], At[m][k], acc[ai][bj][m][n], 0, 0, 0); __builtin_amdgcn_s_setprio(0); } while (0)
#define PG8_WAIT_V(n) asm volatile("s_waitcnt vmcnt(" #n ")" ::: "memory")
#define PG8_WAIT_L(n) asm volatile("s_waitcnt lgkmcnt(" #n ")" ::: "memory")
#define PG8_BAR __builtin_amdgcn_s_barrier()
#define PG8_SCHED __builtin_amdgcn_sched_barrier(0)
    Unit cur, nxt; int ui = 0;
    if (!S.next(0, cur)) return;
    f32x4 acc[2][2][4][2];
#pragma unroll
    for (int a = 0; a < 2; ++a)
#pragma unroll
        for (int b = 0; b < 2; ++b)
#pragma unroll
            for (int m = 0; m < 4; ++m)
#pragma unroll
                for (int n = 0; n < 2; ++n) acc[a][b][m][n] = (f32x4){0.f, 0.f, 0.f, 0.f};
    bf16x8 At[4][2], B0[2][2], B1[2][2];
    const char* cA = (const char*)g.A + (size_t)cur.pm * tstep; const char* cB = (const char*)g.Bt + (size_t)cur.pn * tstep;
    S.a_ready(cur);
    if constexpr (SP2) {
        PG8_STAGE(PG8_SB(0, 0), cB, voffB); PG8_STAGE(PG8_SB(0, 1), cB + hstep, voffB); PG8_STAGE(PG8_SA(0, 0), cA, voffA); PG8_STAGE(PG8_SA(0, 1), cA + hstep, voffA);
        if (wr == 1) PG8_BAR;
        PG8_WAIT_V(2); PG8_BAR;
        PG8_STAGE(PG8_SB(1, 0), cB + kstep, voffB); PG8_STAGE(PG8_SA(1, 0), cA + kstep, voffA); PG8_STAGE(PG8_SB(1, 1), cB + hstep + kstep, voffB);
        PG8_WAIT_V(6); PG8_BAR;
    } else {
        PG8_STAGE(PG8_SB(0, 0), cB, voffB); PG8_STAGE(PG8_SA(0, 0), cA, voffA); PG8_STAGE(PG8_SB(0, 1), cB + hstep, voffB); PG8_STAGE(PG8_SA(0, 1), cA + hstep, voffA);
        if (wr == 1) PG8_BAR;
        PG8_WAIT_V(4); PG8_BAR;
        PG8_STAGE(PG8_SB(1, 0), cB + kstep, voffB); PG8_STAGE(PG8_SA(1, 0), cA + kstep, voffA); PG8_STAGE(PG8_SB(1, 1), cB + hstep + kstep, voffB);
        PG8_WAIT_V(6); PG8_BAR;
    }
    for (;;) {
        const bool has_next = S.next(ui + 1, nxt);
        const char* nA = has_next ? (const char*)g.A + (size_t)nxt.pm * tstep : cA; const char* nB = has_next ? (const char*)g.Bt + (size_t)nxt.pn * tstep : cB;
        for (int t = 0; t < nt; t += 2) {
            const bool last = (t == nt - 2);
            const char* a1 = cA + (size_t)(t + 1) * kstep;
            const char* a2 = last ? nA : cA + (size_t)(t + 2) * kstep; const char* b2 = last ? nB : cB + (size_t)(t + 2) * kstep;
            const char* a3 = a2 + kstep; const char* b3 = b2 + kstep;
            if (last && has_next) S.a_ready(nxt);
            if constexpr (SP2) {
            PG8_LDB(B0, 0, 0); PG8_LDB(B1, 0, 1); PG8_SCHED; PG8_LDA(At, 0, 0); PG8_STAGE(PG8_SA(1, 1), a1 + hstep, voffA);
            PG8_WAIT_V(8); PG8_WAIT_L(0); PG8_BAR; PG8_MMA(0, 0, At, B0); PG8_MMA(0, 1, At, B1); PG8_BAR; PG8_SCHED;
            PG8_LDA(At, 0, 1); PG8_STAGE(PG8_SB(0, 0), b2, voffB); PG8_STAGE(PG8_SB(0, 1), b2 + hstep, voffB); PG8_STAGE(PG8_SA(0, 0), a2, voffA);
            PG8_WAIT_V(8); PG8_WAIT_L(0); PG8_BAR; PG8_MMA(1, 0, At, B0); PG8_MMA(1, 1, At, B1); PG8_BAR; PG8_SCHED;
            PG8_LDB(B0, 1, 0); PG8_LDB(B1, 1, 1); PG8_SCHED; PG8_LDA(At, 1, 0); PG8_STAGE(PG8_SA(0, 1), a2 + hstep, voffA);
            PG8_WAIT_V(8); PG8_WAIT_L(0); PG8_BAR; PG8_MMA(0, 0, At, B0); PG8_MMA(0, 1, At, B1); PG8_BAR; PG8_SCHED;
            PG8_LDA(At, 1, 1); PG8_STAGE(PG8_SB(1, 0), b3, voffB); PG8_STAGE(PG8_SB(1, 1), b3 + hstep, voffB); PG8_STAGE(PG8_SA(1, 0), a3, voffA);
            PG8_WAIT_V(8); PG8_WAIT_L(0); PG8_BAR; PG8_MMA(1, 0, At, B0); PG8_MMA(1, 1, At, B1); PG8_BAR; PG8_SCHED;
            } else {
            PG8_LDB(B0, 0, 0); PG8_SCHED; PG8_LDA(At, 0, 0); PG8_STAGE(PG8_SA(1, 1), a1 + hstep, voffA);
            PG8_WAIT_L(8); PG8_BAR; PG8_WAIT_L(0); PG8_MMA(0, 0, At, B0); PG8_BAR; PG8_SCHED;
            PG8_LDB(B1, 0, 1); PG8_STAGE(PG8_SB(0, 0), b2, voffB);
            PG8_BAR; PG8_WAIT_L(0); PG8_MMA(0, 1, At, B1); PG8_BAR;
            PG8_LDA(At, 0, 1); PG8_STAGE(PG8_SA(0, 0), a2, voffA);
            PG8_BAR; PG8_WAIT_L(0); PG8_MMA(1, 0, At, B0); PG8_BAR; PG8_SCHED;
            PG8_STAGE(PG8_SB(0, 1), b2 + hstep, voffB);
            PG8_WAIT_V(6); PG8_BAR; PG8_MMA(1, 1, At, B1); PG8_BAR;
            PG8_LDB(B0, 1, 0); PG8_SCHED; PG8_LDA(At, 1, 0); PG8_STAGE(PG8_SA(0, 1), a2 + hstep, voffA);
            PG8_WAIT_L(8); PG8_BAR; PG8_WAIT_L(0); PG8_MMA(0, 0, At, B0); PG8_BAR; PG8_SCHED;
            PG8_LDB(B1, 1, 1); PG8_STAGE(PG8_SB(1, 0), b3, voffB);
            PG8_BAR; PG8_WAIT_L(0); PG8_MMA(0, 1, At, B1); PG8_BAR;
            PG8_LDA(At, 1, 1); PG8_STAGE(PG8_SA(1, 0), a3, voffA);
            PG8_BAR; PG8_WAIT_L(0); PG8_MMA(1, 0, At, B0); PG8_BAR; PG8_SCHED;
            PG8_STAGE(PG8_SB(1, 1), b3 + hstep, voffB);
            PG8_WAIT_V(6); PG8_BAR; PG8_MMA(1, 1, At, B1); PG8_BAR;
            }
        }
        if constexpr (ALIGN_EPI) { if (wr == 0) PG8_BAR; }
        if constexpr (!Epi::AFTER_DRAIN) { E(acc, cur, wr, wc, fr, fq); S.done(cur); }
        if (!has_next) break;
#pragma unroll
        for (int a = 0; a < 2; ++a)
#pragma unroll
            for (int b = 0; b < 2; ++b)
#pragma unroll
                for (int m = 0; m < 4; ++m)
#pragma unroll
                    for (int n = 0; n < 2; ++n) acc[a][b][m][n] = (f32x4){0.f, 0.f, 0.f, 0.f};
        cur = nxt; cA = nA; cB = nB; ++ui;
        if constexpr (ALIGN_EPI) { if (wr == 1) PG8_BAR; }
    }
    PG8_WAIT_V(0);
    if constexpr (!ALIGN_EPI) { if (wr == 0) PG8_BAR; }
    PG8_BAR;
    if constexpr (Epi::AFTER_DRAIN) { E.fused(acc, cur, wr, wc, fr, fq, lds, wid, lane); S.done(cur); }
#undef PG8_SA
#undef PG8_SB
#undef PG8_STAGE
#undef PG8_LDA
#undef PG8_LDB
#undef PG8_MMA
#undef PG8_WAIT_V
#undef PG8_WAIT_L
#undef PG8_BAR
#undef PG8_SCHED
}
__device__ __forceinline__ float fsigmoid(float x) { return __builtin_amdgcn_rcpf(1.0f + __expf(-x)); }
__device__ __forceinline__ float bf_lo(unsigned w) { return __uint_as_float(w << 16); }
__device__ __forceinline__ float bf_hi(unsigned w) { return __uint_as_float(w & 0xffff0000u); }
__device__ __forceinline__ u32x4 pack8(const f32x4& v0, const f32x4& v1) { u32x4 w; w.x = cvt_pk_bf16(v0[0], v0[1]); w.y = cvt_pk_bf16(v0[2], v0[3]); w.z = cvt_pk_bf16(v1[0], v1[1]); w.w = cvt_pk_bf16(v1[2], v1[3]); return w; }
__device__ __forceinline__ void unpack8(const u32x4& w, f32x4& v0, f32x4& v1) { v0 = (f32x4){bf_lo(w.x), bf_hi(w.x), bf_lo(w.y), bf_hi(w.y)}; v1 = (f32x4){bf_lo(w.z), bf_hi(w.z), bf_lo(w.w), bf_hi(w.w)}; }

struct EpiProj { static constexpr bool PERM = true, AFTER_DRAIN = false; bf16_t* O;
    __device__ __forceinline__ void operator()(const f32x4 (&acc)[2][2][4][2], const Unit& u, int wr, int wc, int fr, int fq) const {
        const int row0 = u.pm * BM + wr * 64 + fr, col0 = u.pn * BM + wc * 32 + 8 * fq;
        const int mode = (u.pn >= 8) ? 2 : ((u.pn == 2 || u.pn == 3) ? 1 : 0);
#pragma unroll
        for (int ai = 0; ai < 2; ++ai)
#pragma unroll
            for (int m = 0; m < 4; ++m) { bf16_t* rowp = O + (size_t)(row0 + ai * HALF + m * 16) * 4096 + col0;
#pragma unroll
                for (int bj = 0; bj < 2; ++bj) { f32x4 v0 = acc[ai][bj][m][0], v1 = acc[ai][bj][m][1];
                    if (mode == 1) { v0 = v0 * 0.125f; v1 = v1 * 0.125f; }
                    else if (mode == 2) {
#pragma unroll
                        for (int j = 0; j < 4; ++j) { v0[j] = fsigmoid(v0[j]); v1[j] = fsigmoid(v1[j]); } }
                    *(u32x4*)(rowp + bj * HALF) = pack8(v0, v1); } }
    }
};
struct EpiGLU { static constexpr bool PERM = true, AFTER_DRAIN = false; const bf16_t* Y; bf16_t* O; const float* bias;
    __device__ __forceinline__ void operator()(const f32x4 (&acc)[2][2][4][2], const Unit& u, int wr, int wc, int fr, int fq) const {
        const int row0 = u.pm * BM + wr * 64 + fr, col0 = u.pn * BM + wc * 32 + 8 * fq;
#pragma unroll
        for (int ai = 0; ai < 2; ++ai)
#pragma unroll
            for (int m = 0; m < 4; ++m) { const size_t off = (size_t)(row0 + ai * HALF + m * 16) * 512 + col0;
#pragma unroll
                for (int bj = 0; bj < 2; ++bj) { const f32x4 b0 = *(const f32x4*)(bias + col0 + bj * HALF), b1 = *(const f32x4*)(bias + col0 + bj * HALF + 4);
                    f32x4 y0, y1; unpack8(*(const u32x4*)(Y + off + bj * HALF), y0, y1);
                    f32x4 v0 = acc[ai][bj][m][0] + b0, v1 = acc[ai][bj][m][1] + b1;
#pragma unroll
                    for (int j = 0; j < 4; ++j) { v0[j] = y0[j] * fsigmoid(v0[j]); v1[j] = y1[j] * fsigmoid(v1[j]); }
                    *(u32x4*)(O + off + bj * HALF) = pack8(v0, v1); } }
    }
};
template <bool ADD> struct EpiMerge { static constexpr bool PERM = true, AFTER_DRAIN = false; const bf16_t* Gt; bf16_t* O;
    __device__ __forceinline__ void operator()(const f32x4 (&acc)[2][2][4][2], const Unit& u, int wr, int wc, int fr, int fq) const {
        const int row0 = u.pm * BM + wr * 64 + fr, col0 = u.pn * BM + wc * 32 + 8 * fq;
#pragma unroll
        for (int ai = 0; ai < 2; ++ai)
#pragma unroll
            for (int m = 0; m < 4; ++m) { const size_t row = (size_t)(row0 + ai * HALF + m * 16);
#pragma unroll
                for (int bj = 0; bj < 2; ++bj) { f32x4 g0, g1; unpack8(*(const u32x4*)(Gt + row * 4096 + col0 + bj * HALF), g0, g1);
                    f32x4 v0 = acc[ai][bj][m][0] * g0, v1 = acc[ai][bj][m][1] * g1;
                    if (ADD) { f32x4 t0, t1; unpack8(*(const u32x4*)(O + row * 1024 + col0 + bj * HALF), t0, t1); v0 = v0 + t0; v1 = v1 + t1; }
                    *(u32x4*)(O + row * 1024 + col0 + bj * HALF) = pack8(v0, v1); } }
    }
};
struct EpiResid { static constexpr bool PERM = false, AFTER_DRAIN = false; const float* base; float* out; const float* gvec;
    __device__ __forceinline__ void operator()(const f32x4 (&acc)[2][2][4][2], const Unit& u, int wr, int wc, int fr, int fq) const {
        const int row0 = u.pm * BM + wr * 64 + fr, col0 = u.pn * BM + wc * 32 + 4 * fq;
        const float* gb = gvec + (size_t)(u.pm >> 4) * 6144;
        f32x4 gv[2][2];
#pragma unroll
        for (int bj = 0; bj < 2; ++bj)
#pragma unroll
            for (int n = 0; n < 2; ++n) gv[bj][n] = *(const f32x4*)(gb + col0 + bj * HALF + n * 16);
#pragma unroll
        for (int ai = 0; ai < 2; ++ai)
#pragma unroll
            for (int m = 0; m < 4; ++m) { const size_t off = (size_t)(row0 + ai * HALF + m * 16) * 1024 + col0;
#pragma unroll
                for (int bj = 0; bj < 2; ++bj)
#pragma unroll
                    for (int n = 0; n < 2; ++n) { const f32x4 b = *(const f32x4*)(base + off + bj * HALF + n * 16);
                        *(f32x4*)(out + off + bj * HALF + n * 16) = b + gv[bj][n] * acc[ai][bj][m][n]; } }
    }
};
struct EpiSwiGLU { static constexpr bool PERM = true, AFTER_DRAIN = false; bf16_t* O;
    __device__ __forceinline__ void operator()(const f32x4 (&acc)[2][2][4][2], const Unit& u, int wr, int wc, int fr, int fq) const {
        const int row0 = u.pm * BM + wr * 64 + fr, col0 = u.pn * HALF + wc * 32 + 8 * fq;
#pragma unroll
        for (int ai = 0; ai < 2; ++ai)
#pragma unroll
            for (int m = 0; m < 4; ++m) { f32x4 v0, v1;
#pragma unroll
                for (int j = 0; j < 4; ++j) { const float g0 = acc[ai][0][m][0][j], g1 = acc[ai][0][m][1][j];
                    v0[j] = g0 * fsigmoid(g0) * acc[ai][1][m][0][j]; v1[j] = g1 * fsigmoid(g1) * acc[ai][1][m][1][j]; }
                *(u32x4*)(O + (size_t)(row0 + ai * HALF + m * 16) * 2816 + col0) = pack8(v0, v1); }
    }
};
}

using pg8::bf16_t; using pg8::bf16x8; using pg8::f32x4; using pg8::u32x4;
#define LAS __attribute__((address_space(3)))
typedef float f32x16 __attribute__((ext_vector_type(16)));
constexpr int BATCH = 4, T = 4096, D = 1024, M = BATCH * T, NIN = 4096, FF = 2816, SG = 32, SP = 64, SW = 512, NCH = 64  ;
constexpr float RMS_EPS = 1e-6f;
constexpr float STICK_THETA = 40.0f;
constexpr size_t MiB = 1u << 20;
constexpr size_t WS_MOD = 0, WS_LBAR = 128 * 1024, WS_BBAR = 256 * 1024, WS_BAR = 512 * 1024, BAR_BYTES = 16384;
constexpr size_t WS_WIN = 1 * MiB, WS_WGLU = 9 * MiB, WS_WA = 10 * MiB, WS_WB = 11 * MiB, WS_WO = 12 * MiB, WS_WGU = 14 * MiB, WS_WD = 25 * MiB;
constexpr size_t WS_H = 32 * MiB;
constexpr size_t WS_PROJ = 64 * MiB;
constexpr size_t WS_ATTN = 192 * MiB, WS_YSSM = 208 * MiB, WS_S5OUT = 224 * MiB, WS_ENDS = 240 * MiB, WS_END = 244 * MiB;
constexpr int LDS_BYTES = 131072 + 1024;

struct Args {
    const float *x, *c, *w_ada, *b_ada, *norm1_g, *w_in, *lam_re, *lam_im, *log_dt, *b_re, *b_im, *c_re, *c_im, *d_skip, *w_glu, *b_glu, *w_a, *w_b, *w_o, *norm2_g, *w_gate, *w_up, *w_down, *norm_f_g;
    float* out; unsigned char* ws;
};

__device__ __forceinline__ unsigned f2bf(float f) { unsigned u = __float_as_uint(f); return (u + 0x7fffu + ((u >> 16) & 1u)) >> 16; }
__device__ __forceinline__ unsigned pk2(float lo, float hi) { return f2bf(lo) | (f2bf(hi) << 16); }
__device__ __forceinline__ float bf2f(unsigned short b) { return __uint_as_float(((unsigned)b) << 16); }
#define LDS_WAIT() asm volatile("s_waitcnt lgkmcnt(0)" ::: "memory")
__device__ __forceinline__ float wave_sum(float v) {
#pragma unroll
    for (int o = 1; o < 64; o <<= 1) v += __shfl_xor(v, o);
    return v;
}

#define GAS __attribute__((address_space(1)))
#define XB_TMO      128
#define XB_XCNT(j)  (256  + 64 * (j))
#define XB_XSUB(j)  (1280 + 64 * (j))
#define XB_XGEN(j)  (2304 + 64 * (j))
#define XB_TOP      3328
#define XB_TOPGEN   3392
#define XCD_BAR_WORDS 3456
#define XB_SPIN_CAP (1u << 18)

__device__ __forceinline__ unsigned xb_ld(unsigned* p)              { return __hip_atomic_load(p, __ATOMIC_RELAXED, __HIP_MEMORY_SCOPE_AGENT); }
__device__ __forceinline__ unsigned xb_add(unsigned* p, unsigned v) { return __hip_atomic_fetch_add(p, v, __ATOMIC_RELAXED, __HIP_MEMORY_SCOPE_AGENT); }
__device__ __forceinline__ unsigned xb_xcc_id() { return (unsigned)__builtin_amdgcn_s_getreg((3 << 11) | 20) & 0xFu; }
#define XB_SPIN(cond, bar) do { unsigned _sp = 0; while (cond) { __builtin_amdgcn_s_sleep(1); \
    if ((++_sp & 255u) == 0u) { if (xb_ld(&(bar)[XB_TMO])) break; if (_sp > XB_SPIN_CAP) { atomicAdd(&(bar)[XB_TMO], 1u); break; } } } } while (0)

struct XcdBarrier {
    unsigned* bar; unsigned x;
    volatile LAS unsigned* st;
};

__device__ __forceinline__ XcdBarrier xcd_barrier_post(unsigned* bar, volatile LAS unsigned* st) {
    XcdBarrier b; b.bar = bar; b.x = xb_xcc_id(); b.st = st;
    if (threadIdx.x == 0) (void)xb_add(&bar[XB_XCNT(b.x)], 1u);
    return b;
}
__device__ __forceinline__ void xcd_barrier_complete(unsigned* bar, unsigned x, unsigned& nloc, unsigned& nx) {
    const unsigned G = gridDim.x * gridDim.y * gridDim.z;
    unsigned sum, cnt, mine, sp = 0u;
    for (;;) {
        sum = 0u; cnt = 0u; mine = 0u;
#pragma unroll
        for (unsigned j = 0; j < 16; ++j) { const unsigned c = xb_ld(&bar[XB_XCNT(j)]); sum += c; cnt += (c > 0u) ? 1u : 0u; mine = (j == x) ? c : mine; }
        if (sum == G) break;
        __builtin_amdgcn_s_sleep(1);
        if ((++sp & 255u) == 0u) { if (xb_ld(&bar[XB_TMO])) break; if (sp > XB_SPIN_CAP) { atomicAdd(&bar[XB_TMO], 1u); break; } }
    }
    nloc = mine > 0u ? mine : 1u; nx = cnt > 0u ? cnt : 1u;
}

__device__ __forceinline__ void xcd_barrier(const XcdBarrier& b) {
    asm volatile("s_waitcnt vmcnt(0)" ::: "memory");
    __syncthreads();
    if (threadIdx.x == 0) {
        unsigned* bar = b.bar;
        __builtin_amdgcn_s_waitcnt(0);
        unsigned nloc = b.st[0], nx = b.st[1];
        if (nloc == 0u) { xcd_barrier_complete(bar, b.x, nloc, nx); b.st[0] = nloc; b.st[1] = nx; }
        const unsigned old = xb_add(&bar[XB_XSUB(b.x)], 1u);
        const unsigned gen = old / nloc;
        if (old + 1u == (gen + 1u) * nloc) {
            __builtin_amdgcn_fence(__ATOMIC_RELEASE, "agent");
            asm volatile("s_waitcnt vmcnt(0)" ::: "memory");
            const unsigned og = xb_add(&bar[XB_TOP], 1u);
            const unsigned tg = og / nx;
            if (og + 1u == (tg + 1u) * nx) xb_add(&bar[XB_TOPGEN], 1u);
            else XB_SPIN(xb_ld(&bar[XB_TOPGEN]) == tg, bar);
            __builtin_amdgcn_fence(__ATOMIC_ACQUIRE, "agent");
            xb_add(&bar[XB_XGEN(b.x)], 1u);
            asm volatile("s_waitcnt vmcnt(0)" ::: "memory");
        } else {
            XB_SPIN(xb_ld(&bar[XB_XGEN(b.x)]) == gen, bar);
            __builtin_amdgcn_fence(__ATOMIC_ACQUIRE, "agent");
            asm volatile("s_waitcnt vmcnt(0)" ::: "memory");
        }
    }
    __syncthreads();
}

__device__ __forceinline__ void transpose_item(const float* W, int K, int N, bf16_t* WT, int orow0, int k0, int n0, LAS float* scr, int lane) {
#pragma unroll 32
    for (int i = 0; i < 32; ++i) { const int kk = 2 * i + (lane >> 5); scr[kk * 33 + (lane & 31)] = W[(size_t)(k0 + kk) * N + n0 + (lane & 31)]; }
    LDS_WAIT();
    const int c = lane & 7;
#pragma unroll
    for (int j = 0; j < 4; ++j) { const int n = (lane >> 3) + 8 * j; const LAS float* s = scr + (8 * c) * 33 + n;
        u32x4 o; o.x = pk2(s[0 * 33], s[1 * 33]); o.y = pk2(s[2 * 33], s[3 * 33]); o.z = pk2(s[4 * 33], s[5 * 33]); o.w = pk2(s[6 * 33], s[7 * 33]);
        *(u32x4*)(WT + (size_t)(orow0 + n) * K + k0 + 8 * c) = o; }
    LDS_WAIT();
}
__device__ __forceinline__ void transpose_mat(const float* W, int K, int N, bf16_t* WT, int mode, int item, LAS float* scr, int lane) {
    const int nblk = N / 32, kb = item / nblk, nb = item % nblk, n0 = 32 * nb;
    const int orow0 = mode == 0 ? n0 : ((n0 >> 7) * 256 + (n0 & 127) + (mode == 2 ? 128 : 0));
    transpose_item(W, K, N, WT, orow0, 64 * kb, n0, scr, lane);
}

__device__ __forceinline__ bf16x8 pack_step8(float a0, float a1, float a2, float a3, float a4, float a5, float a6, float a7) {
    u32x4 p;
    asm volatile("v_cvt_pk_bf16_f32 %0, %4, %5\n\tv_cvt_pk_bf16_f32 %1, %6, %7\n\tv_cvt_pk_bf16_f32 %2, %8, %9\n\tv_cvt_pk_bf16_f32 %3, %10, %11\n\ts_nop 1"
                 : "=&v"(p[0]), "=&v"(p[1]), "=&v"(p[2]), "=&v"(p[3]) : "v"(a0), "v"(a1), "v"(a2), "v"(a3), "v"(a4), "v"(a5), "v"(a6), "v"(a7));
    return __builtin_bit_cast(bf16x8, p);
}
#define MFMA32(a, b, c) __builtin_amdgcn_mfma_f32_32x32x16_bf16((a), (b), (c), 0, 0, 0)
__device__ __forceinline__ void attn_item(const bf16_t* proj, bf16_t* attn, int item, int lane) {
    const int qt = item & 127, hd = (item >> 7) & 7, b = item >> 10;
    const int r = lane & 31, h = lane >> 5, q0 = qt * 32;
    const size_t rowbase = (size_t)b * T;
    bf16x8 qf[4];
    { const bf16_t* qp = proj + (rowbase + q0 + r) * NIN + 512 + hd * 64 + 8 * h;
#pragma unroll
      for (int s = 0; s < 4; ++s) qf[s] = *(const bf16x8*)(qp + 16 * s); }
    f32x16 o0, o1;
#pragma unroll
    for (int i = 0; i < 16; ++i) { o0[i] = 0.f; o1[i] = 0.f; }
    float R = 0.f;
    const int tq = q0 + r;
    for (int k0 = q0; k0 >= 0; k0 -= 32) {
        bf16x8 kf[4];
        { const bf16_t* kp = proj + (rowbase + k0 + r) * NIN + 1024 + hd * 64 + 8 * h;
#pragma unroll
          for (int s = 0; s < 4; ++s) kf[s] = *(const bf16x8*)(kp + 16 * s); }
        bf16x8 vf[2][2];
        { const bf16_t* vp = proj + (rowbase + k0 + 4 * h) * NIN + 1536 + hd * 64 + r;
#pragma unroll
          for (int mt = 0; mt < 2; ++mt)
#pragma unroll
            for (int s2 = 0; s2 < 2; ++s2)
#pragma unroll
              for (int j = 0; j < 8; ++j) vf[mt][s2][j] = (short)vp[(size_t)(16 * s2 + 8 * (j >> 2) + (j & 3)) * NIN + 32 * mt]; }
        f32x16 z;
#pragma unroll
        for (int i = 0; i < 16; ++i) z[i] = 0.f;
#pragma unroll
        for (int s = 0; s < 4; ++s) z = MFMA32(kf[s], qf[s], z);
        float sp[16], gs[4], og[4];
        const bool diag = (k0 == q0);
#pragma unroll
        for (int i = 0; i < 16; ++i) { const int key = k0 + (i & 3) + 8 * (i >> 2) + 4 * h; const float zz = z[i];
            const float s = fmaxf(zz, 0.f) + __logf(1.0f + __expf(-fabsf(zz)));
            sp[i] = (!diag || key < tq) ? s : 0.f; }
#pragma unroll
        for (int g = 0; g < 4; ++g) { gs[g] = (sp[4 * g] + sp[4 * g + 1]) + (sp[4 * g + 2] + sp[4 * g + 3]); og[g] = __shfl_xor(gs[g], 32); }
        float w[16]; float run = R;
#pragma unroll
        for (int g = 3; g >= 0; --g) { float a = run + (h == 0 ? og[g] : 0.f);
#pragma unroll
            for (int j = 3; j >= 0; --j) { const int i = 4 * g + j; const int key = k0 + j + 8 * g + 4 * h; a += sp[i];
                const float e = __expf(z[i] - a); w[i] = (!diag || key < tq) ? e : 0.f; }
            run += gs[g] + og[g]; }
        R = run;
        const bf16x8 w0 = pack_step8(w[0], w[1], w[2], w[3], w[4], w[5], w[6], w[7]);
        const bf16x8 w1 = pack_step8(w[8], w[9], w[10], w[11], w[12], w[13], w[14], w[15]);
        o0 = MFMA32(vf[0][0], w0, o0); o0 = MFMA32(vf[0][1], w1, o0);
        o1 = MFMA32(vf[1][0], w0, o1); o1 = MFMA32(vf[1][1], w1, o1);
        if (__all(R > STICK_THETA)) break;
    }
    bf16_t* op = attn + (rowbase + q0 + r) * SW + hd * 64 + 4 * h;
#pragma unroll
    for (int g = 0; g < 4; ++g) {
        uint2 a; a.x = pk2(o0[4 * g], o0[4 * g + 1]); a.y = pk2(o0[4 * g + 2], o0[4 * g + 3]); *(uint2*)(op + 8 * g) = a;
        uint2 c; c.x = pk2(o1[4 * g], o1[4 * g + 1]); c.y = pk2(o1[4 * g + 2], o1[4 * g + 3]); *(uint2*)(op + 32 + 8 * g) = c; }
}

__device__ __forceinline__ float gelu_tanh(float y) { const float t = 1.5957691216057308f * (y + 0.044715f * y * y * y); return y * __builtin_amdgcn_rcpf(1.0f + __expf(-t)); }
template <int PASS> __device__ __forceinline__ void s5_item(const Args& a, int item, LAS unsigned char* wl, int lane) {
    const int ch = item & 63, g = (item >> 6) & 31, b = item >> 11, gp = g * 64 + lane;
    const bf16_t* proj = (const bf16_t*)(a.ws + WS_PROJ);
    LAS float* ul = (LAS float*)wl;
    LAS unsigned short* Sl = (LAS unsigned short*)(wl + 4096);
    { const bf16_t* up = proj + ((size_t)(b * T + ch * 64 + lane)) * NIN + g * 16;
      const u32x4 a0 = *(const u32x4*)up, a1 = *(const u32x4*)(up + 8);
      f32x4 v0, v1, v2, v3; pg8::unpack8(a0, v0, v1); pg8::unpack8(a1, v2, v3);
      LAS f32x4* d = (LAS f32x4*)(ul + lane * 16); d[0] = v0; d[1] = v1; d[2] = v2; d[3] = v3; }
    const float* lb = (const float*)(a.ws + WS_LBAR);
    const float lr = lb[gp], li = lb[2048 + gp];
    float br[16], bi[16];
    { const f32x4* pr = (const f32x4*)((const float*)(a.ws + WS_BBAR) + (size_t)gp * 16); const f32x4* pi = (const f32x4*)((const float*)(a.ws + WS_BBAR) + 32768 + (size_t)gp * 16);
#pragma unroll
      for (int i = 0; i < 4; ++i) { const f32x4 x = pr[i], y = pi[i];
#pragma unroll
        for (int j = 0; j < 4; ++j) { br[4 * i + j] = x[j]; bi[4 * i + j] = y[j]; } } }
    float sr = 0.f, si = 0.f;
    float* ends_re = (float*)(a.ws + WS_ENDS); float* ends_im = ends_re + (size_t)BATCH * SG * NCH * SP;
    bf16x8 cf[4];
    f32x4 dsk;
    if (PASS == 1) {
        const float Lr = lb[4096 + gp], Li = lb[6144 + gp];
        const float* er = ends_re + ((size_t)(b * SG + g) * NCH) * SP + lane; const float* ei = ends_im + ((size_t)(b * SG + g) * NCH) * SP + lane;
        for (int c2 = 0; c2 < ch; c2 += 16) { float xr[16], xi[16];
#pragma unroll
            for (int i = 0; i < 16; ++i) { const int cc = (c2 + i < ch) ? (c2 + i) : (ch - 1); xr[i] = er[cc * SP]; xi[i] = ei[cc * SP]; }
#pragma unroll
            for (int i = 0; i < 16; ++i) { const bool ok = (c2 + i < ch); const float nr = Lr * sr - Li * si + xr[i], ni = Lr * si + Li * sr + xi[i]; sr = ok ? nr : sr; si = ok ? ni : si; } }
        const int i = lane & 15, fq = lane >> 4;
#pragma unroll
        for (int ks = 0; ks < 4; ++ks) { const float* src = (ks < 2 ? a.c_re : a.c_im) + ((size_t)(g * 16 + i)) * SP + 32 * (ks & 1) + 8 * fq;
            const f32x4 x0 = *(const f32x4*)src, x1 = *(const f32x4*)(src + 4); const float sg = ks < 2 ? 1.f : -1.f;
            u32x4 p; p.x = pk2(sg * x0[0], sg * x0[1]); p.y = pk2(sg * x0[2], sg * x0[3]); p.z = pk2(sg * x1[0], sg * x1[1]); p.w = pk2(sg * x1[2], sg * x1[3]);
            cf[ks] = __builtin_bit_cast(bf16x8, p); }
        dsk = *(const f32x4*)(a.d_skip + g * 16 + 4 * fq);
    }
    LDS_WAIT();
    for (int sub = 0; sub < 4; ++sub) {
#pragma unroll 4
        for (int tt = 0; tt < 16; ++tt) {
            const LAS f32x4* up4 = (const LAS f32x4*)(ul + (sub * 16 + tt) * 16);
            const f32x4 u0 = up4[0], u1 = up4[1], u2 = up4[2], u3 = up4[3];
            float bur = 0.f, bui = 0.f;
#pragma unroll
            for (int j = 0; j < 4; ++j) { bur += br[j] * u0[j]; bui += bi[j] * u0[j]; }
#pragma unroll
            for (int j = 0; j < 4; ++j) { bur += br[4 + j] * u1[j]; bui += bi[4 + j] * u1[j]; }
#pragma unroll
            for (int j = 0; j < 4; ++j) { bur += br[8 + j] * u2[j]; bui += bi[8 + j] * u2[j]; }
#pragma unroll
            for (int j = 0; j < 4; ++j) { bur += br[12 + j] * u3[j]; bui += bi[12 + j] * u3[j]; }
            const float nr = lr * sr - li * si + bur, ni = lr * si + li * sr + bui; sr = nr; si = ni;
            if (PASS == 1) { Sl[tt * 136 + lane] = (unsigned short)f2bf(sr); Sl[tt * 136 + 64 + lane] = (unsigned short)f2bf(si); }
        }
        if (PASS == 1) {
            LDS_WAIT();
            const int fr = lane & 15, fq = lane >> 4;
            f32x4 y = (f32x4){0.f, 0.f, 0.f, 0.f};
#pragma unroll
            for (int ks = 0; ks < 4; ++ks) { const bf16x8 af = *(const LAS bf16x8*)(Sl + fr * 136 + 32 * ks + 8 * fq);
                y = __builtin_amdgcn_mfma_f32_16x16x32_bf16(cf[ks], af, y, 0, 0, 0); }
            const f32x4 uu = *(const LAS f32x4*)(ul + (sub * 16 + fr) * 16 + 4 * fq);
            uint2 o; o.x = pk2(gelu_tanh(y[0] + dsk[0] * uu[0]), gelu_tanh(y[1] + dsk[1] * uu[1])); o.y = pk2(gelu_tanh(y[2] + dsk[2] * uu[2]), gelu_tanh(y[3] + dsk[3] * uu[3]));
            *(uint2*)((bf16_t*)(a.ws + WS_YSSM) + ((size_t)(b * T + ch * 64 + sub * 16 + fr)) * SW + g * 16 + 4 * fq) = o;
            LDS_WAIT();
        }
    }
    if (PASS == 0) { ends_re[(size_t)item * SP + lane] = sr; ends_im[(size_t)item * SP + lane] = si; }
}

__device__ __forceinline__ float row_ss(const f32x4 (&v)[4]) { float s = 0.f;
#pragma unroll
    for (int j = 0; j < 4; ++j) s += (v[j][0] * v[j][0] + v[j][1] * v[j][1]) + (v[j][2] * v[j][2] + v[j][3] * v[j][3]);
    return s; }
template <int MODE> __device__ __forceinline__ void norm_rows8(const float* xbase, bf16_t* obase, const float* gn, const float* shift, const float* scale, int lane) {
    f32x4 ca[4], cb[4];
#pragma unroll
    for (int j = 0; j < 4; ++j) { const f32x4 g = ((const f32x4*)gn)[lane + 64 * j];
        if (MODE == 0) { const f32x4 sc = ((const f32x4*)scale)[lane + 64 * j]; ca[j] = g * (sc + 1.0f); cb[j] = ((const f32x4*)shift)[lane + 64 * j]; } else { ca[j] = g; cb[j] = (f32x4){0.f, 0.f, 0.f, 0.f}; } }
#pragma unroll 1
    for (int r = 0; r < 8; r += 2) {
        const f32x4* x0 = (const f32x4*)(xbase + (size_t)r * D) + lane; const f32x4* x1 = (const f32x4*)(xbase + (size_t)(r + 1) * D) + lane;
        f32x4 v0[4], v1[4];
#pragma unroll
        for (int j = 0; j < 4; ++j) { v0[j] = x0[64 * j]; v1[j] = x1[64 * j]; }
        float s0 = row_ss(v0), s1 = row_ss(v1);
#pragma unroll
        for (int o = 1; o < 64; o <<= 1) { s0 += __shfl_xor(s0, o); s1 += __shfl_xor(s1, o); }
        const float r0 = 1.0f / sqrtf(s0 * (1.0f / D) + RMS_EPS), r1 = 1.0f / sqrtf(s1 * (1.0f / D) + RMS_EPS);
        if (MODE == 0) { uint2* o0 = (uint2*)(obase + (size_t)r * D) + lane; uint2* o1 = (uint2*)(obase + (size_t)(r + 1) * D) + lane;
#pragma unroll
            for (int j = 0; j < 4; ++j) { const f32x4 h0 = v0[j] * r0 * ca[j] + cb[j], h1 = v1[j] * r1 * ca[j] + cb[j];
                uint2 w0; w0.x = pk2(h0[0], h0[1]); w0.y = pk2(h0[2], h0[3]); o0[64 * j] = w0; uint2 w1; w1.x = pk2(h1[0], h1[1]); w1.y = pk2(h1[2], h1[3]); o1[64 * j] = w1; } }
        else { f32x4* o0 = (f32x4*)(xbase + (size_t)r * D) + lane; f32x4* o1 = (f32x4*)(xbase + (size_t)(r + 1) * D) + lane;
#pragma unroll
            for (int j = 0; j < 4; ++j) { o0[64 * j] = v0[j] * r0 * ca[j]; o1[64 * j] = v1[j] * r1 * ca[j]; } }
    }
}

__global__ void __launch_bounds__(512, 2) mega_fwd(Args a) {
    extern __shared__ __attribute__((aligned(16))) unsigned char lds_raw[];
    LAS unsigned char* lds = (LAS unsigned char*)lds_raw;
    cg::grid_group grid = cg::this_grid();
    if (a.ws == nullptr) grid.sync();
    const int tid = threadIdx.x, lane = tid & 63, wave = __builtin_amdgcn_readfirstlane(tid >> 6);
    const int Gd = gridDim.x, bx = blockIdx.x, gw = bx * 8 + wave, NGW = Gd * 8;
    unsigned char* ws = a.ws;
    { volatile LAS unsigned* st = (volatile LAS unsigned*)(lds + 131072); if (tid < 2) st[tid] = 0u; }
    __syncthreads();
    const XcdBarrier bar = xcd_barrier_post((unsigned*)(ws + WS_BAR), (volatile LAS unsigned*)(lds + 131072));
    float* mod = (float*)(ws + WS_MOD);
    bf16_t* Win_t = (bf16_t*)(ws + WS_WIN); bf16_t* Wglu_t = (bf16_t*)(ws + WS_WGLU); bf16_t* Wa_t = (bf16_t*)(ws + WS_WA); bf16_t* Wb_t = (bf16_t*)(ws + WS_WB);
    bf16_t* Wo_t = (bf16_t*)(ws + WS_WO); bf16_t* Wgu_t = (bf16_t*)(ws + WS_WGU); bf16_t* Wd_t = (bf16_t*)(ws + WS_WD);
    bf16_t* Hb = (bf16_t*)(ws + WS_H); bf16_t* proj = (bf16_t*)(ws + WS_PROJ); bf16_t* hidden = (bf16_t*)(ws + WS_PROJ);
    bf16_t* attn = (bf16_t*)(ws + WS_ATTN); bf16_t* yssm = (bf16_t*)(ws + WS_YSSM); bf16_t* s5out = (bf16_t*)(ws + WS_S5OUT);

    {
        LAS float* cond = (LAS float*)lds;
        LAS float* red = (LAS float*)(lds + 16384);
        if (bx < 192) {
            for (int i = tid; i < 4 * D; i += 512) { const float cv = a.c[i]; cond[i] = cv * __builtin_amdgcn_rcpf(1.0f + __expf(-cv)); }
            __syncthreads();
            for (int it = bx; it < 192; it += Gd) {
                const int j = it * 32 + (lane & 31), hf = lane >> 5; float acc[4] = {0.f, 0.f, 0.f, 0.f};
                const float* wp = a.w_ada + (size_t)(wave * 128 + hf) * 6144 + j; const LAS float* cp = cond + wave * 128 + hf;
#pragma unroll 16
                for (int k = 0; k < 64; ++k) { const float wv = wp[(size_t)(2 * k) * 6144];
#pragma unroll
                    for (int bb = 0; bb < 4; ++bb) acc[bb] += cp[bb * D + 2 * k] * wv; }
#pragma unroll
                for (int bb = 0; bb < 4; ++bb) { acc[bb] += __shfl_xor(acc[bb], 32); if (lane < 32) red[(wave * 4 + bb) * 32 + lane] = acc[bb]; }
                __syncthreads();
                if (tid < 128) { const int bb = tid >> 5, jj = it * 32 + (tid & 31); float sres = a.b_ada[jj];
#pragma unroll
                    for (int w = 0; w < 8; ++w) sres += red[(w * 4 + bb) * 32 + (tid & 31)];
                    mod[bb * 6144 + jj] = sres; }
                __syncthreads();
            }
        }
        { const int gp = bx * 512 + tid;
          if (gp < SG * SP) { const int g = gp >> 6;
            const float dt = expf(a.log_dt[g]), lr = a.lam_re[gp], li = a.lam_im[gp], zr = lr * dt, zi = li * dt;
            const float em = expm1f(zr), cs = cosf(zi), sn = sinf(zi), sh = sinf(0.5f * zi);
            const float m1r = em * cs - 2.0f * sh * sh, m1i = (em + 1.0f) * sn;
            const float lbr = 1.0f + m1r, lbi = m1i;
            const float inv = 1.0f / (lr * lr + li * li);
            const float cr = (m1r * lr + m1i * li) * inv, ci = (m1i * lr - m1r * li) * inv;
            float pr = lbr, pi = lbi;
#pragma unroll
            for (int k = 0; k < 6; ++k) { const float nr = pr * pr - pi * pi, ni = 2.0f * pr * pi; pr = nr; pi = ni; }
            float* lb = (float*)(ws + WS_LBAR); lb[gp] = lbr; lb[2048 + gp] = lbi; lb[4096 + gp] = pr; lb[6144 + gp] = pi;
            float* bbr = (float*)(ws + WS_BBAR) + (size_t)gp * 16; float* bbi = (float*)(ws + WS_BBAR) + 32768 + (size_t)gp * 16;
#pragma unroll
            for (int i = 0; i < 16; ++i) { const float xr = a.b_re[(size_t)gp * 16 + i], xi = a.b_im[(size_t)gp * 16 + i]; bbr[i] = cr * xr - ci * xi; bbi[i] = cr * xi + ci * xr; } } }
        LAS float* scr = (LAS float*)(lds + wave * 16384);
        constexpr int I_IN = (D / 64) * (NIN / 32), I_GLU = (SW / 64) * (SW / 32), I_A = (SW / 64) * (D / 32), I_O = (D / 64) * (D / 32), I_G = (D / 64) * (FF / 32), I_D = (FF / 64) * (D / 32);
        constexpr int NITEMS = I_IN + I_GLU + 2 * I_A + I_O + 2 * I_G + I_D;
        for (int it = gw; it < NITEMS; it += NGW) {
            int r = it;
            if (r < I_IN) { transpose_mat(a.w_in, D, NIN, Win_t, 0, r, scr, lane); continue; } r -= I_IN;
            if (r < I_GLU) { transpose_mat(a.w_glu, SW, SW, Wglu_t, 0, r, scr, lane); continue; } r -= I_GLU;
            if (r < I_A) { transpose_mat(a.w_a, SW, D, Wa_t, 0, r, scr, lane); continue; } r -= I_A;
            if (r < I_A) { transpose_mat(a.w_b, SW, D, Wb_t, 0, r, scr, lane); continue; } r -= I_A;
            if (r < I_O) { transpose_mat(a.w_o, D, D, Wo_t, 0, r, scr, lane); continue; } r -= I_O;
            if (r < I_G) { transpose_mat(a.w_gate, D, FF, Wgu_t, 1, r, scr, lane); continue; } r -= I_G;
            if (r < I_G) { transpose_mat(a.w_up, D, FF, Wgu_t, 2, r, scr, lane); continue; } r -= I_G;
            transpose_mat(a.w_down, FF, D, Wd_t, 0, r, scr, lane);
        }
    }
    xcd_barrier(bar);
    for (int m = gw * 8; m < M; m += NGW * 8) { const float* mb = mod + (size_t)(m >> 12) * 6144; norm_rows8<0>(a.x + (size_t)m * D, Hb + (size_t)m * D, a.norm1_g, mb, mb + 1024, lane); }
    xcd_barrier(bar);
    { pg8::Gemm g{Hb, Win_t, M, NIN, D}; pg8::StaticOrder S; S.init(M, NIN, Gd, bx); pg8::EpiProj E{proj};
      pg8::gemm_phase<pg8::EpiProj, pg8::StaticOrder, true, true>(lds, g, S, E); }
    xcd_barrier(bar);
    for (int it = gw; it < BATCH * 8 * (T / 32); it += NGW) attn_item(proj, attn, it, lane);
    for (int it = gw; it < BATCH * SG * NCH; it += NGW) s5_item<0>(a, it, lds + wave * 16384, lane);
    xcd_barrier(bar);
    for (int it = gw; it < BATCH * SG * NCH; it += NGW) s5_item<1>(a, it, lds + wave * 16384, lane);
    xcd_barrier(bar);
    { pg8::Gemm g{yssm, Wglu_t, M, SW, SW}; pg8::StaticOrder S; S.init(M, SW, Gd, bx); pg8::EpiGLU E{yssm, s5out, a.b_glu};
      pg8::gemm_phase<pg8::EpiGLU, pg8::StaticOrder, true, true>(lds, g, S, E); }
    xcd_barrier(bar);
    { pg8::Gemm g{s5out, Wa_t, M, D, SW}; pg8::StaticOrder S; S.init(M, D, Gd, bx); pg8::EpiMerge<false> E{proj + 2048, Hb};
      pg8::gemm_phase<pg8::EpiMerge<false>, pg8::StaticOrder, true, true>(lds, g, S, E); }
    { pg8::Gemm g{attn, Wb_t, M, D, SW}; pg8::StaticOrder S; S.init(M, D, Gd, bx); pg8::EpiMerge<true> E{proj + 3072, Hb};
      pg8::gemm_phase<pg8::EpiMerge<true>, pg8::StaticOrder, true, true>(lds, g, S, E); }
    xcd_barrier(bar);
    { pg8::Gemm g{Hb, Wo_t, M, D, D}; pg8::StaticOrder S; S.init(M, D, Gd, bx); pg8::EpiResid E{a.x, a.out, mod + 2 * 1024};
      pg8::gemm_phase<pg8::EpiResid, pg8::StaticOrder, true, true>(lds, g, S, E); }
    xcd_barrier(bar);
    for (int m = gw * 8; m < M; m += NGW * 8) { const float* mb = mod + (size_t)(m >> 12) * 6144; norm_rows8<0>(a.out + (size_t)m * D, Hb + (size_t)m * D, a.norm2_g, mb + 3 * 1024, mb + 4 * 1024, lane); }
    xcd_barrier(bar);
    { pg8::Gemm g{Hb, Wgu_t, M, 2 * FF, D}; pg8::StaticOrder S; S.init(M, 2 * FF, Gd, bx); pg8::EpiSwiGLU E{hidden};
      pg8::gemm_phase<pg8::EpiSwiGLU, pg8::StaticOrder, true, true>(lds, g, S, E); }
    xcd_barrier(bar);
    { pg8::Gemm g{hidden, Wd_t, M, D, FF}; pg8::StaticOrder S; S.init(M, D, Gd, bx); pg8::EpiResid E{a.out, a.out, mod + 5 * 1024};
      pg8::gemm_phase<pg8::EpiResid, pg8::StaticOrder, true, true>(lds, g, S, E); }
    xcd_barrier(bar);
    for (int m = gw * 8; m < M; m += NGW * 8) norm_rows8<1>(a.out + (size_t)m * D, nullptr, a.norm_f_g, nullptr, nullptr, lane);
}

extern "C" void kernel_launch(void* const* d_in, const int* in_sizes, int n_in, void* d_out, int out_size, void* d_ws, size_t ws_size, hipStream_t stream) {
    static int grid = 0;
    if (grid == 0) {
        if (n_in != 24 || ws_size < WS_END) { fprintf(stderr, "kernel_launch: unexpected inputs (n_in %d, ws %zu)\n", n_in, ws_size); grid = -1; return; }
        int dev = 0, cus = 0, per_cu = 0;
        hipGetDevice(&dev); hipDeviceGetAttribute(&cus, hipDeviceAttributeMultiprocessorCount, dev);
        if (hipFuncSetAttribute((const void*)mega_fwd, hipFuncAttributeMaxDynamicSharedMemorySize, LDS_BYTES) != hipSuccess) { fprintf(stderr, "kernel_launch: hipFuncSetAttribute failed\n"); grid = -1; return; }
        if (hipOccupancyMaxActiveBlocksPerMultiprocessor(&per_cu, (const void*)mega_fwd, 512, LDS_BYTES) != hipSuccess || per_cu < 1) { fprintf(stderr, "kernel_launch: occupancy query says %d\n", per_cu); per_cu = 1; }
        (void)hipGetLastError();
        grid = cus;
    }
    if (grid < 0) return;
    if (hipMemsetAsync((char*)d_ws + WS_BAR, 0, BAR_BYTES, stream) != hipSuccess) { fprintf(stderr, "kernel_launch: memset failed\n"); return; }
    Args a{};
    const float** ap = (const float**)&a;
    for (int i = 0; i < 24; ++i) ap[i] = (const float*)d_in[i];
    a.out = (float*)d_out; a.ws = (unsigned char*)d_ws;
    void* args[] = {&a};
    hipError_t e = hipLaunchCooperativeKernel((const void*)mega_fwd, dim3(grid), dim3(512), args, LDS_BYTES, stream);
    if (e != hipSuccess) fprintf(stderr, "cooperative launch failed: %s (grid %d)\n", hipGetErrorString(e), grid);
}
```

```cpp
#include <hip/hip_runtime.h>
#include <hip/hip_cooperative_groups.h>
#include <cstdio>
#include <cstdint>
namespace cg = cooperative_groups;
namespace pg8 {
#define PG8_LAS __attribute__((address_space(3)))
typedef unsigned short bf16_t;
typedef short bf16x8 __attribute__((ext_vector_type(8)));
typedef float f32x4 __attribute__((ext_vector_type(4)));
typedef unsigned u32x4 __attribute__((ext_vector_type(4)));
constexpr int BM = 256, BK = 64, HALF = 128, HTB = HALF * BK * 2  , STAGE_BYTES = 8 * HTB, NXCD = 8, WGM = 8;

__host__ __device__ __forceinline__ int lds_byte(int r, int c) { const int st = (r >> 4) * 2 + (c >> 5), rr = r & 15, cc = c & 31, ob = rr * 64 + cc * 2; return st * 1024 + (ob ^ (((ob >> 9) & 1) << 5)); }
__host__ __device__ __forceinline__ void stage_rc(int b, int& R, int& C) { const int st = b / 1024, sb = b % 1024, swz = sb ^ (((sb >> 9) & 1) << 5); R = (st >> 1) * 16 + swz / 64; C = (st & 1) * 32 + (swz % 64) / 2; }
__host__ __device__ __forceinline__ int perm32(int rho) { const int n = rho >> 4, i = rho & 15; return 8 * (i >> 2) + 4 * n + (i & 3); }

struct Unit { int pm, pn; };
struct Gemm { const bf16_t* A; const bf16_t* Bt; int M, N, K; };

struct StaticOrder {
    int nM, nN, nwg, G, c;
    __host__ __device__ void init(int M, int N, int G_, int c_) { nM = M / BM; nN = N / BM; nwg = nM * nN; G = G_; c = c_; }
    __host__ __device__ bool next(int i, Unit& u) const {
        const long L = (long)i * G + c; if (L >= nwg) return false;
        int wgid = (int)L; { const int q = nwg / NXCD, r = nwg % NXCD, xcd = wgid % NXCD, off = wgid / NXCD; wgid = (xcd < r ? xcd * (q + 1) : r * (q + 1) + (xcd - r) * q) + off; }
        const int nig = WGM * nN, gid = wgid / nig, fm = gid * WGM, gsz = (nM - fm) < WGM ? (nM - fm) : WGM;
        u.pm = fm + ((wgid % nig) % gsz); u.pn = (wgid % nig) / gsz; return true;
    }
    __device__ __forceinline__ void a_ready(const Unit&) const {}
    __device__ __forceinline__ void done(const Unit&) const {}
};
__device__ __forceinline__ unsigned cvt_pk_bf16(float lo, float hi) { unsigned r; asm volatile("v_cvt_pk_bf16_f32 %0, %1, %2" : "=v"(r) : "v"(lo), "v"(hi)); return r; }
template <class Epi, class Sched, bool ALIGN_EPI = false, bool SP2 = false>
__device__ __forceinline__ void gemm_phase(PG8_LAS unsigned char* lds, const Gemm g, const Sched& S, const Epi& E) {
    const int tid = threadIdx.x, wid = __builtin_amdgcn_readfirstlane(tid >> 6), lane = tid & 63, wr = wid >> 2, wc = wid & 3, fr = lane & 15, fq = lane >> 4;
    const int K = g.K, nt = K / BK;
    unsigned voffA[2], voffB[2];
#pragma unroll
    for (int i = 0; i < 2; ++i) { int R, C; stage_rc(tid * 16 + i * 8192, R, C); const int Rb = Epi::PERM ? ((R & ~31) + perm32(R & 31)) : R;
        voffA[i] = (unsigned)(R * K + C) * 2u; voffB[i] = (unsigned)(Rb * K + C) * 2u; }
    const size_t kstep = (size_t)(BK * 2);
    const size_t hstep = (size_t)HALF * K * 2;
    const size_t tstep = 2 * hstep;
    const unsigned ldsw = (unsigned)wid * 1024u;
    const int aoff = lds_byte(wr * 64 + fr, fq * 8), boff = lds_byte(wc * 32 + fr, fq * 8);
#define PG8_SA(b, h) (((b) * 2 + (h)) * HTB)
#define PG8_SB(b, h) ((4 + (b) * 2 + (h)) * HTB)
#define PG8_STAGE(bufoff, gbase, voff) do { _Pragma("unroll") for (int _i = 0; _i < 2; ++_i) \
        __builtin_amdgcn_global_load_lds((const unsigned*)((const char*)(gbase) + (voff)[_i]), (PG8_LAS unsigned*)(lds + (bufoff) + ldsw + _i * 8192), 16, 0, 0); } while (0)
#define PG8_LDA(dst, b, h) do { _Pragma("unroll") for (int m = 0; m < 4; ++m) _Pragma("unroll") for (int k = 0; k < 2; ++k) dst[m][k] = *(const PG8_LAS bf16x8*)(lds + PG8_SA(b, h) + aoff + m * 2048 + k * 1024); } while (0)
#define PG8_LDB(dst, b, h) do { _Pragma("unroll") for (int n = 0; n < 2; ++n) _Pragma("unroll") for (int k = 0; k < 2; ++k) dst[n][k] = *(const PG8_LAS bf16x8*)(lds + PG8_SB(b, h) + boff + n * 2048 + k * 1024); } while (0)
#define PG8_MMA(ai, bj, At, Bt) do { __builtin_amdgcn_s_setprio(1); _Pragma("unroll") for (int m = 0; m < 4; ++m) _Pragma("unroll") for (int n = 0; n < 2; ++n) _Pragma("unroll") for (int k = 0; k < 2; ++k) \
        acc[ai][bj][m][n] = __builtin_amdgcn_mfma_f32_16x16x32_bf16(Bt[n][k], At[m][k], acc[ai][bj][m][n], 0, 0, 0); __builtin_amdgcn_s_setprio(0); } while (0)
#define PG8_WAIT_V(n) asm volatile("s_waitcnt vmcnt(" #n ")" ::: "memory")
#define PG8_WAIT_L(n) asm volatile("s_waitcnt lgkmcnt(" #n ")" ::: "memory")
#define PG8_BAR __builtin_amdgcn_s_barrier()
#define PG8_SCHED __builtin_amdgcn_sched_barrier(0)
    Unit cur, nxt; int ui = 0;
    if (!S.next(0, cur)) return;
    f32x4 acc[2][2][4][2];
#pragma unroll
    for (int a = 0; a < 2; ++a)
#pragma unroll
        for (int b = 0; b < 2; ++b)
#pragma unroll
            for (int m = 0; m < 4; ++m)
#pragma unroll
                for (int n = 0; n < 2; ++n) acc[a][b][m][n] = (f32x4){0.f, 0.f, 0.f, 0.f};
    bf16x8 At[4][2], B0[2][2], B1[2][2];
    const char* cA = (const char*)g.A + (size_t)cur.pm * tstep; const char* cB = (const char*)g.Bt + (size_t)cur.pn * tstep;
    S.a_ready(cur);
    if constexpr (SP2) {
        PG8_STAGE(PG8_SB(0, 0), cB, voffB); PG8_STAGE(PG8_SB(0, 1), cB + hstep, voffB); PG8_STAGE(PG8_SA(0, 0), cA, voffA); PG8_STAGE(PG8_SA(0, 1), cA + hstep, voffA);
        if (wr == 1) PG8_BAR;
        PG8_WAIT_V(2); PG8_BAR;
        PG8_STAGE(PG8_SB(1, 0), cB + kstep, voffB); PG8_STAGE(PG8_SA(1, 0), cA + kstep, voffA); PG8_STAGE(PG8_SB(1, 1), cB + hstep + kstep, voffB);
        PG8_WAIT_V(6); PG8_BAR;
    } else {
        PG8_STAGE(PG8_SB(0, 0), cB, voffB); PG8_STAGE(PG8_SA(0, 0), cA, voffA); PG8_STAGE(PG8_SB(0, 1), cB + hstep, voffB); PG8_STAGE(PG8_SA(0, 1), cA + hstep, voffA);
        if (wr == 1) PG8_BAR;
        PG8_WAIT_V(4); PG8_BAR;
        PG8_STAGE(PG8_SB(1, 0), cB + kstep, voffB); PG8_STAGE(PG8_SA(1, 0), cA + kstep, voffA); PG8_STAGE(PG8_SB(1, 1), cB + hstep + kstep, voffB);
        PG8_WAIT_V(6); PG8_BAR;
    }
    for (;;) {
        const bool has_next = S.next(ui + 1, nxt);
        const char* nA = has_next ? (const char*)g.A + (size_t)nxt.pm * tstep : cA; const char* nB = has_next ? (const char*)g.Bt + (size_t)nxt.pn * tstep : cB;
        for (int t = 0; t < nt; t += 2) {
            const bool last = (t == nt - 2);
            const char* a1 = cA + (size_t)(t + 1) * kstep;
            const char* a2 = last ? nA : cA + (size_t)(t + 2) * kstep; const char* b2 = last ? nB : cB + (size_t)(t + 2) * kstep;
            const char* a3 = a2 + kstep; const char* b3 = b2 + kstep;
            if (last && has_next) S.a_ready(nxt);
            if constexpr (SP2) {
            PG8_LDB(B0, 0, 0); PG8_LDB(B1, 0, 1); PG8_SCHED; PG8_LDA(At, 0, 0); PG8_STAGE(PG8_SA(1, 1), a1 + hstep, voffA);
            PG8_WAIT_V(8); PG8_WAIT_L(0); PG8_BAR; PG8_MMA(0, 0, At, B0); PG8_MMA(0, 1, At, B1); PG8_BAR; PG8_SCHED;
            PG8_LDA(At, 0, 1); PG8_STAGE(PG8_SB(0, 0), b2, voffB); PG8_STAGE(PG8_SB(0, 1), b2 + hstep, voffB); PG8_STAGE(PG8_SA(0, 0), a2, voffA);
            PG8_WAIT_V(8); PG8_WAIT_L(0); PG8_BAR; PG8_MMA(1, 0, At, B0); PG8_MMA(1, 1, At, B1); PG8_BAR; PG8_SCHED;
            PG8_LDB(B0, 1, 0); PG8_LDB(B1, 1, 1); PG8_SCHED; PG8_LDA(At, 1, 0); PG8_STAGE(PG8_SA(0, 1), a2 + hstep, voffA);
            PG8_WAIT_V(8); PG8_WAIT_L(0); PG8_BAR; PG8_MMA(0, 0, At, B0); PG8_MMA(0, 1, At, B1); PG8_BAR; PG8_SCHED;
            PG8_LDA(At, 1, 1); PG8_STAGE(PG8_SB(1, 0), b3, voffB); PG8_STAGE(PG8_SB(1, 1), b3 + hstep, voffB); PG8_STAGE(PG8_SA(1, 0), a3, voffA);
            PG8_WAIT_V(8); PG8_WAIT_L(0); PG8_BAR; PG8_MMA(1, 0, At, B0); PG8_MMA(1, 1, At, B1); PG8_BAR; PG8_SCHED;
            } else {
            PG8_LDB(B0, 0, 0); PG8_SCHED; PG8_LDA(At, 0, 0); PG8_STAGE(PG8_SA(1, 1), a1 + hstep, voffA);
            PG8_WAIT_L(8); PG8_BAR; PG8_WAIT_L(0); PG8_MMA(0, 0, At, B0); PG8_BAR; PG8_SCHED;
            PG8_LDB(B1, 0, 1); PG8_STAGE(PG8_SB(0, 0), b2, voffB);
            PG8_BAR; PG8_WAIT_L(0); PG8_MMA(0, 1, At, B1); PG8_BAR;
            PG8_LDA(At, 0, 1); PG8_STAGE(PG8_SA(0, 0), a2, voffA);
            PG8_BAR; PG8_WAIT_L(0); PG8_MMA(1, 0, At, B0); PG8_BAR; PG8_SCHED;
            PG8_STAGE(PG8_SB(0, 1), b2 + hstep, voffB);
            PG8_WAIT_V(6); PG8_BAR; PG8_MMA(1, 1, At, B1); PG8_BAR;
            PG8_LDB(B0, 1, 0); PG8_SCHED; PG8_LDA(At, 1, 0); PG8_STAGE(PG8_SA(0, 1), a2 + hstep, voffA);
            PG8_WAIT_L(8); PG8_BAR; PG8_WAIT_L(0); PG8_MMA(0, 0, At, B0); PG8_BAR; PG8_SCHED;
            PG8_LDB(B1, 1, 1); PG8_STAGE(PG8_SB(1, 0), b3, voffB);
            PG8_BAR; PG8_WAIT_L(0); PG8_MMA(0, 1, At, B1); PG8_BAR;
            PG8_LDA(At, 1, 1); PG8_STAGE(PG8_SA(1, 0), a3, voffA);
            PG8_BAR; PG8_WAIT_L(0); PG8_MMA(1, 0, At, B0); PG8_BAR; PG8_SCHED;
            PG8_STAGE(PG8_SB(1, 1), b3 + hstep, voffB);
            PG8_WAIT_V(6); PG8_BAR; PG8_MMA(1, 1, At, B1); PG8_BAR;
            }
        }
        if constexpr (ALIGN_EPI) { if (wr == 0) PG8_BAR; }
        if constexpr (!Epi::AFTER_DRAIN) { E(acc, cur, wr, wc, fr, fq); S.done(cur); }
        if (!has_next) break;
#pragma unroll
        for (int a = 0; a < 2; ++a)
#pragma unroll
            for (int b = 0; b < 2; ++b)
#pragma unroll
                for (int m = 0; m < 4; ++m)
#pragma unroll
                    for (int n = 0; n < 2; ++n) acc[a][b][m][n] = (f32x4){0.f, 0.f, 0.f, 0.f};
        cur = nxt; cA = nA; cB = nB; ++ui;
        if constexpr (ALIGN_EPI) { if (wr == 1) PG8_BAR; }
    }
    PG8_WAIT_V(0);
    if constexpr (!ALIGN_EPI) { if (wr == 0) PG8_BAR; }
    PG8_BAR;
    if constexpr (Epi::AFTER_DRAIN) { E.fused(acc, cur, wr, wc, fr, fq, lds, wid, lane); S.done(cur); }
#undef PG8_SA
#undef PG8_SB
#undef PG8_STAGE
#undef PG8_LDA
#undef PG8_LDB
#undef PG8_MMA
#undef PG8_WAIT_V
#undef PG8_WAIT_L
#undef PG8_BAR
#undef PG8_SCHED
}
__device__ __forceinline__ float fsigmoid(float x) { return __builtin_amdgcn_rcpf(1.0f + __expf(-x)); }
__device__ __forceinline__ float bf_lo(unsigned w) { return __uint_as_float(w << 16); }
__device__ __forceinline__ float bf_hi(unsigned w) { return __uint_as_float(w & 0xffff0000u); }
__device__ __forceinline__ u32x4 pack8(const f32x4& v0, const f32x4& v1) { u32x4 w; w.x = cvt_pk_bf16(v0[0], v0[1]); w.y = cvt_pk_bf16(v0[2], v0[3]); w.z = cvt_pk_bf16(v1[0], v1[1]); w.w = cvt_pk_bf16(v1[2], v1[3]); return w; }
__device__ __forceinline__ void unpack8(const u32x4& w, f32x4& v0, f32x4& v1) { v0 = (f32x4){bf_lo(w.x), bf_hi(w.x), bf_lo(w.y), bf_hi(w.y)}; v1 = (f32x4){bf_lo(w.z), bf_hi(w.z), bf_lo(w.w), bf_hi(w.w)}; }

struct EpiProj { static constexpr bool PERM = true, AFTER_DRAIN = false; bf16_t* O;
    __device__ __forceinline__ void operator()(const f32x4 (&acc)[2][2][4][2], const Unit& u, int wr, int wc, int fr, int fq) const {
        const int row0 = u.pm * BM + wr * 64 + fr, col0 = u.pn * BM + wc * 32 + 8 * fq;
        const int mode = (u.pn >= 8) ? 2 : ((u.pn == 2 || u.pn == 3) ? 1 : 0);
#pragma unroll
        for (int ai = 0; ai < 2; ++ai)
#pragma unroll
            for (int m = 0; m < 4; ++m) { bf16_t* rowp = O + (size_t)(row0 + ai * HALF + m * 16) * 4096 + col0;
#pragma unroll
                for (int bj = 0; bj < 2; ++bj) { f32x4 v0 = acc[ai][bj][m][0], v1 = acc[ai][bj][m][1];
                    if (mode == 1) { v0 = v0 * 0.125f; v1 = v1 * 0.125f; }
                    else if (mode == 2) {
#pragma unroll
                        for (int j = 0; j < 4; ++j) { v0[j] = fsigmoid(v0[j]); v1[j] = fsigmoid(v1[j]); } }
                    *(u32x4*)(rowp + bj * HALF) = pack8(v0, v1); } }
    }
};
struct EpiGLU { static constexpr bool PERM = true, AFTER_DRAIN = false; const bf16_t* Y; bf16_t* O; const float* bias;
    __device__ __forceinline__ void operator()(const f32x4 (&acc)[2][2][4][2], const Unit& u, int wr, int wc, int fr, int fq) const {
        const int row0 = u.pm * BM + wr * 64 + fr, col0 = u.pn * BM + wc * 32 + 8 * fq;
#pragma unroll
        for (int ai = 0; ai < 2; ++ai)
#pragma unroll
            for (int m = 0; m < 4; ++m) { const size_t off = (size_t)(row0 + ai * HALF + m * 16) * 512 + col0;
#pragma unroll
                for (int bj = 0; bj < 2; ++bj) { const f32x4 b0 = *(const f32x4*)(bias + col0 + bj * HALF), b1 = *(const f32x4*)(bias + col0 + bj * HALF + 4);
                    f32x4 y0, y1; unpack8(*(const u32x4*)(Y + off + bj * HALF), y0, y1);
                    f32x4 v0 = acc[ai][bj][m][0] + b0, v1 = acc[ai][bj][m][1] + b1;
#pragma unroll
                    for (int j = 0; j < 4; ++j) { v0[j] = y0[j] * fsigmoid(v0[j]); v1[j] = y1[j] * fsigmoid(v1[j]); }
                    *(u32x4*)(O + off + bj * HALF) = pack8(v0, v1); } }
    }
};
template <bool ADD> struct EpiMerge { static constexpr bool PERM = true, AFTER_DRAIN = false; const bf16_t* Gt; bf16_t* O;
    __device__ __forceinline__ void operator()(const f32x4 (&acc)[2][2][4][2], const Unit& u, int wr, int wc, int fr, int fq) const {
        const int row0 = u.pm * BM + wr * 64 + fr, col0 = u.pn * BM + wc * 32 + 8 * fq;
#pragma unroll
        for (int ai = 0; ai < 2; ++ai)
#pragma unroll
            for (int m = 0; m < 4; ++m) { const size_t row = (size_t)(row0 + ai * HALF + m * 16);
#pragma unroll
                for (int bj = 0; bj < 2; ++bj) { f32x4 g0, g1; unpack8(*(const u32x4*)(Gt + row * 4096 + col0 + bj * HALF), g0, g1);
                    f32x4 v0 = acc[ai][bj][m][0] * g0, v1 = acc[ai][bj][m][1] * g1;
                    if (ADD) { f32x4 t0, t1; unpack8(*(const u32x4*)(O + row * 1024 + col0 + bj * HALF), t0, t1); v0 = v0 + t0; v1 = v1 + t1; }
                    *(u32x4*)(O + row * 1024 + col0 + bj * HALF) = pack8(v0, v1); } }
    }
};
struct EpiResid { static constexpr bool PERM = false, AFTER_DRAIN = false; const float* base; float* out; const float* gvec;
    __device__ __forceinline__ void operator()(const f32x4 (&acc)[2][2][4][2], const Unit& u, int wr, int wc, int fr, int fq) const {
        const int row0 = u.pm * BM + wr * 64 + fr, col0 = u.pn * BM + wc * 32 + 4 * fq;
        const float* gb = gvec + (size_t)(u.pm >> 4) * 6144;
        f32x4 gv[2][2];
#pragma unroll
        for (int bj = 0; bj < 2; ++bj)
#pragma unroll
            for (int n = 0; n < 2; ++n) gv[bj][n] = *(const f32x4*)(gb + col0 + bj * HALF + n * 16);
#pragma unroll
        for (int ai = 0; ai < 2; ++ai)
#pragma unroll
            for (int m = 0; m < 4; ++m) { const size_t off = (size_t)(row0 + ai * HALF + m * 16) * 1024 + col0;
#pragma unroll
                for (int bj = 0; bj < 2; ++bj)
#pragma unroll
                    for (int n = 0; n < 2; ++n) { const f32x4 b = *(const f32x4*)(base + off + bj * HALF + n * 16);
                        *(f32x4*)(out + off + bj * HALF + n * 16) = b + gv[bj][n] * acc[ai][bj][m][n]; } }
    }
};
struct EpiSwiGLU { static constexpr bool PERM = true, AFTER_DRAIN = false; bf16_t* O;
    __device__ __forceinline__ void operator()(const f32x4 (&acc)[2][2][4][2], const Unit& u, int wr, int wc, int fr, int fq) const {
        const int row0 = u.pm * BM + wr * 64 + fr, col0 = u.pn * HALF + wc * 32 + 8 * fq;
#pragma unroll
        for (int ai = 0; ai < 2; ++ai)
#pragma unroll
            for (int m = 0; m < 4; ++m) { f32x4 v0, v1;
#pragma unroll
                for (int j = 0; j < 4; ++j) { const float g0 = acc[ai][0][m][0][j], g1 = acc[ai][0][m][1][j];
                    v0[j] = g0 * fsigmoid(g0) * acc[ai][1][m][0][j]; v1[j] = g1 * fsigmoid(g1) * acc[ai][1][m][1][j]; }
                *(u32x4*)(O + (size_t)(row0 + ai * HALF + m * 16) * 2816 + col0) = pack8(v0, v1); }
    }
};
}

using pg8::bf16_t; using pg8::bf16x8; using pg8::f32x4; using pg8::u32x4;
#define LAS __attribute__((address_space(3)))
typedef float f32x16 __attribute__((ext_vector_type(16)));
constexpr int BATCH = 4, T = 4096, D = 1024, M = BATCH * T, NIN = 4096, FF = 2816, SG = 32, SP = 64, SW = 512, NCH = 64  ;
constexpr float RMS_EPS = 1e-6f;
constexpr float STICK_THETA = 40.0f;
constexpr size_t MiB = 1u << 20;
constexpr size_t WS_MOD = 0, WS_LBAR = 128 * 1024, WS_BBAR = 256 * 1024, WS_BAR = 512 * 1024, BAR_BYTES = 16384;
constexpr size_t WS_WIN = 1 * MiB, WS_WGLU = 9 * MiB, WS_WA = 10 * MiB, WS_WB = 11 * MiB, WS_WO = 12 * MiB, WS_WGU = 14 * MiB, WS_WD = 25 * MiB;
constexpr size_t WS_H = 32 * MiB;
constexpr size_t WS_PROJ = 64 * MiB;
constexpr size_t WS_ATTN = 192 * MiB, WS_YSSM = 208 * MiB, WS_S5OUT = 224 * MiB, WS_ENDS = 240 * MiB, WS_END = 244 * MiB;
constexpr int LDS_BYTES = 131072 + 1024;

struct Args {
    const float *x, *c, *w_ada, *b_ada, *norm1_g, *w_in, *lam_re, *lam_im, *log_dt, *b_re, *b_im, *c_re, *c_im, *d_skip, *w_glu, *b_glu, *w_a, *w_b, *w_o, *norm2_g, *w_gate, *w_up, *w_down, *norm_f_g;
    float* out; unsigned char* ws;
};

__device__ __forceinline__ unsigned f2bf(float f) { unsigned u = __float_as_uint(f); return (u + 0x7fffu + ((u >> 16) & 1u)) >> 16; }
__device__ __forceinline__ unsigned pk2(float lo, float hi) { return f2bf(lo) | (f2bf(hi) << 16); }
__device__ __forceinline__ float bf2f(unsigned short b) { return __uint_as_float(((unsigned)b) << 16); }
#define LDS_WAIT() asm volatile("s_waitcnt lgkmcnt(0)" ::: "memory")
__device__ __forceinline__ float wave_sum(float v) {
#pragma unroll
    for (int o = 1; o < 64; o <<= 1) v += __shfl_xor(v, o);
    return v;
}

#define GAS __attribute__((address_space(1)))
#define XB_TMO      128
#define XB_XCNT(j)  (256  + 64 * (j))
#define XB_XSUB(j)  (1280 + 64 * (j))
#define XB_XGEN(j)  (2304 + 64 * (j))
#define XB_TOP      3328
#define XB_TOPGEN   3392
#define XCD_BAR_WORDS 3456
#define XB_SPIN_CAP (1u << 18)

__device__ __forceinline__ unsigned xb_ld(unsigned* p)              { return __hip_atomic_load(p, __ATOMIC_RELAXED, __HIP_MEMORY_SCOPE_AGENT); }
__device__ __forceinline__ unsigned xb_add(unsigned* p, unsigned v) { return __hip_atomic_fetch_add(p, v, __ATOMIC_RELAXED, __HIP_MEMORY_SCOPE_AGENT); }
__device__ __forceinline__ unsigned xb_xcc_id() { return (unsigned)__builtin_amdgcn_s_getreg((3 << 11) | 20) & 0xFu; }
#define XB_SPIN(cond, bar) do { unsigned _sp = 0; while (cond) { __builtin_amdgcn_s_sleep(1); \
    if ((++_sp & 255u) == 0u) { if (xb_ld(&(bar)[XB_TMO])) break; if (_sp > XB_SPIN_CAP) { atomicAdd(&(bar)[XB_TMO], 1u); break; } } } } while (0)

struct XcdBarrier {
    unsigned* bar; unsigned x;
    volatile LAS unsigned* st;
};

__device__ __forceinline__ XcdBarrier xcd_barrier_post(unsigned* bar, volatile LAS unsigned* st) {
    XcdBarrier b; b.bar = bar; b.x = xb_xcc_id(); b.st = st;
    if (threadIdx.x == 0) (void)xb_add(&bar[XB_XCNT(b.x)], 1u);
    return b;
}
__device__ __forceinline__ void xcd_barrier_complete(unsigned* bar, unsigned x, unsigned& nloc, unsigned& nx) {
    const unsigned G = gridDim.x * gridDim.y * gridDim.z;
    unsigned sum, cnt, mine, sp = 0u;
    for (;;) {
        sum = 0u; cnt = 0u; mine = 0u;
#pragma unroll
        for (unsigned j = 0; j < 16; ++j) { const unsigned c = xb_ld(&bar[XB_XCNT(j)]); sum += c; cnt += (c > 0u) ? 1u : 0u; mine = (j == x) ? c : mine; }
        if (sum == G) break;
        __builtin_amdgcn_s_sleep(1);
        if ((++sp & 255u) == 0u) { if (xb_ld(&bar[XB_TMO])) break; if (sp > XB_SPIN_CAP) { atomicAdd(&bar[XB_TMO], 1u); break; } }
    }
    nloc = mine > 0u ? mine : 1u; nx = cnt > 0u ? cnt : 1u;
}

__device__ __forceinline__ void xcd_barrier(const XcdBarrier& b) {
    asm volatile("s_waitcnt vmcnt(0)" ::: "memory");
    __syncthreads();
    if (threadIdx.x == 0) {
        unsigned* bar = b.bar;
        __builtin_amdgcn_s_waitcnt(0);
        unsigned nloc = b.st[0], nx = b.st[1];
        if (nloc == 0u) { xcd_barrier_complete(bar, b.x, nloc, nx); b.st[0] = nloc; b.st[1] = nx; }
        const unsigned old = xb_add(&bar[XB_XSUB(b.x)], 1u);
        const unsigned gen = old / nloc;
        if (old + 1u == (gen + 1u) * nloc) {
            __builtin_amdgcn_fence(__ATOMIC_RELEASE, "agent");
            asm volatile("s_waitcnt vmcnt(0)" ::: "memory");
            const unsigned og = xb_add(&bar[XB_TOP], 1u);
            const unsigned tg = og / nx;
            if (og + 1u == (tg + 1u) * nx) xb_add(&bar[XB_TOPGEN], 1u);
            else XB_SPIN(xb_ld(&bar[XB_TOPGEN]) == tg, bar);
            __builtin_amdgcn_fence(__ATOMIC_ACQUIRE, "agent");
            xb_add(&bar[XB_XGEN(b.x)], 1u);
            asm volatile("s_waitcnt vmcnt(0)" ::: "memory");
        } else {
            XB_SPIN(xb_ld(&bar[XB_XGEN(b.x)]) == gen, bar);
            __builtin_amdgcn_fence(__ATOMIC_ACQUIRE, "agent");
            asm volatile("s_waitcnt vmcnt(0)" ::: "memory");
        }
    }
    __syncthreads();
}

__device__ __forceinline__ void transpose_item(const float* W, int K, int N, bf16_t* WT, int orow0, int k0, int n0, LAS float* scr, int lane) {
#pragma unroll 32
    for (int i = 0; i < 32; ++i) { const int kk = 2 * i + (lane >> 5); scr[kk * 33 + (lane & 31)] = W[(size_t)(k0 + kk) * N + n0 + (lane & 31)]; }
    LDS_WAIT();
    const int c = lane & 7;
#pragma unroll
    for (int j = 0; j < 4; ++j) { const int n = (lane >> 3) + 8 * j; const LAS float* s = scr + (8 * c) * 33 + n;
        u32x4 o; o.x = pk2(s[0 * 33], s[1 * 33]); o.y = pk2(s[2 * 33], s[3 * 33]); o.z = pk2(s[4 * 33], s[5 * 33]); o.w = pk2(s[6 * 33], s[7 * 33]);
        *(u32x4*)(WT + (size_t)(orow0 + n) * K + k0 + 8 * c) = o; }
    LDS_WAIT();
}
__device__ __forceinline__ void transpose_mat(const float* W, int K, int N, bf16_t* WT, int mode, int item, LAS float* scr, int lane) {
    const int nblk = N / 32, kb = item / nblk, nb = item % nblk, n0 = 32 * nb;
    const int orow0 = mode == 0 ? n0 : ((n0 >> 7) * 256 + (n0 & 127) + (mode == 2 ? 128 : 0));
    transpose_item(W, K, N, WT, orow0, 64 * kb, n0, scr, lane);
}

__device__ __forceinline__ bf16x8 pack_step8(float a0, float a1, float a2, float a3, float a4, float a5, float a6, float a7) {
    u32x4 p;
    asm volatile("v_cvt_pk_bf16_f32 %0, %4, %5\n\tv_cvt_pk_bf16_f32 %1, %6, %7\n\tv_cvt_pk_bf16_f32 %2, %8, %9\n\tv_cvt_pk_bf16_f32 %3, %10, %11\n\ts_nop 1"
                 : "=&v"(p[0]), "=&v"(p[1]), "=&v"(p[2]), "=&v"(p[3]) : "v"(a0), "v"(a1), "v"(a2), "v"(a3), "v"(a4), "v"(a5), "v"(a6), "v"(a7));
    return __builtin_bit_cast(bf16x8, p);
}
#define MFMA32(a, b, c) __builtin_amdgcn_mfma_f32_32x32x16_bf16((a), (b), (c), 0, 0, 0)
__device__ __forceinline__ void attn_item(const bf16_t* proj, bf16_t* attn, int item, int lane) {
    const int qt = item & 127, hd = (item >> 7) & 7, b = item >> 10;
    const int r = lane & 31, h = lane >> 5, q0 = qt * 32;
    const size_t rowbase = (size_t)b * T;
    bf16x8 qf[4];
    { const bf16_t* qp = proj + (rowbase + q0 + r) * NIN + 512 + hd * 64 + 8 * h;
#pragma unroll
      for (int s = 0; s < 4; ++s) qf[s] = *(const bf16x8*)(qp + 16 * s); }
    f32x16 o0, o1;
#pragma unroll
    for (int i = 0; i < 16; ++i) { o0[i] = 0.f; o1[i] = 0.f; }
    float R = 0.f;
    const int tq = q0 + r;
    for (int k0 = q0; k0 >= 0; k0 -= 32) {
        bf16x8 kf[4];
        { const bf16_t* kp = proj + (rowbase + k0 + r) * NIN + 1024 + hd * 64 + 8 * h;
#pragma unroll
          for (int s = 0; s < 4; ++s) kf[s] = *(const bf16x8*)(kp + 16 * s); }
        bf16x8 vf[2][2];
        { const bf16_t* vp = proj + (rowbase + k0 + 4 * h) * NIN + 1536 + hd * 64 + r;
#pragma unroll
          for (int mt = 0; mt < 2; ++mt)
#pragma unroll
            for (int s2 = 0; s2 < 2; ++s2)
#pragma unroll
              for (int j = 0; j < 8; ++j) vf[mt][s2][j] = (short)vp[(size_t)(16 * s2 + 8 * (j >> 2) + (j & 3)) * NIN + 32 * mt]; }
        f32x16 z;
#pragma unroll
        for (int i = 0; i < 16; ++i) z[i] = 0.f;
#pragma unroll
        for (int s = 0; s < 4; ++s) z = MFMA32(kf[s], qf[s], z);
        float sp[16], gs[4], og[4];
        const bool diag = (k0 == q0);
#pragma unroll
        for (int i = 0; i < 16; ++i) { const int key = k0 + (i & 3) + 8 * (i >> 2) + 4 * h; const float zz = z[i];
            const float s = fmaxf(zz, 0.f) + __logf(1.0f + __expf(-fabsf(zz)));
            sp[i] = (!diag || key < tq) ? s : 0.f; }
#pragma unroll
        for (int g = 0; g < 4; ++g) { gs[g] = (sp[4 * g] + sp[4 * g + 1]) + (sp[4 * g + 2] + sp[4 * g + 3]); og[g] = __shfl_xor(gs[g], 32); }
        float w[16]; float run = R;
#pragma unroll
        for (int g = 3; g >= 0; --g) { float a = run + (h == 0 ? og[g] : 0.f);
#pragma unroll
            for (int j = 3; j >= 0; --j) { const int i = 4 * g + j; const int key = k0 + j + 8 * g + 4 * h; a += sp[i];
                const float e = __expf(z[i] - a); w[i] = (!diag || key < tq) ? e : 0.f; }
            run += gs[g] + og[g]; }
        R = run;
        const bf16x8 w0 = pack_step8(w[0], w[1], w[2], w[3], w[4], w[5], w[6], w[7]);
        const bf16x8 w1 = pack_step8(w[8], w[9], w[10], w[11], w[12], w[13], w[14], w[15]);
        o0 = MFMA32(vf[0][0], w0, o0); o0 = MFMA32(vf[0][1], w1, o0);
        o1 = MFMA32(vf[1][0], w0, o1); o1 = MFMA32(vf[1][1], w1, o1);
        if (__all(R > STICK_THETA)) break;
    }
    bf16_t* op = attn + (rowbase + q0 + r) * SW + hd * 64 + 4 * h;
#pragma unroll
    for (int g = 0; g < 4; ++g) {
        uint2 a; a.x = pk2(o0[4 * g], o0[4 * g + 1]); a.y = pk2(o0[4 * g + 2], o0[4 * g + 3]); *(uint2*)(op + 8 * g) = a;
        uint2 c; c.x = pk2(o1[4 * g], o1[4 * g + 1]); c.y = pk2(o1[4 * g + 2], o1[4 * g + 3]); *(uint2*)(op + 32 + 8 * g) = c; }
}

__device__ __forceinline__ float gelu_tanh(float y) { const float t = 1.5957691216057308f * (y + 0.044715f * y * y * y); return y * __builtin_amdgcn_rcpf(1.0f + __expf(-t)); }
template <int PASS> __device__ __forceinline__ void s5_item(const Args& a, int item, LAS unsigned char* wl, int lane) {
    const int ch = item & 63, g = (item >> 6) & 31, b = item >> 11, gp = g * 64 + lane;
    const int r = lane & 31, h = lane >> 5;
    const bf16_t* proj = (const bf16_t*)(a.ws + WS_PROJ);
    LAS unsigned short* Sl = (LAS unsigned short*)wl;
    const float* lb = (const float*)(a.ws + WS_LBAR);
    const float lr = lb[gp], li = lb[2048 + gp];
    bf16x8 bfr[4];
    { const bf16_t* bb = (const bf16_t*)(a.ws + WS_BBAR);
#pragma unroll
      for (int nt = 0; nt < 4; ++nt) bfr[nt] = *(const bf16x8*)(bb + (nt >> 1) * 32768 + (size_t)(g * 64 + r + 32 * (nt & 1)) * 16 + 8 * h); }
    const bf16_t* ubase = proj + ((size_t)(b * T + ch * 64)) * NIN + g * 16;
    bf16x8 uf[2];
#pragma unroll
    for (int hc = 0; hc < 2; ++hc) uf[hc] = *(const bf16x8*)(ubase + (size_t)(hc * 32 + r) * NIN + 8 * h);
    float sr = 0.f, si = 0.f;
    float* ends_re = (float*)(a.ws + WS_ENDS); float* ends_im = ends_re + (size_t)BATCH * SG * NCH * SP;
    bf16x8 cf[4];
    f32x4 dsk;
    uint2 usk[4];
    const int fr = lane & 15, fq = lane >> 4;
    if (PASS == 1) {
#pragma unroll
        for (int sub = 0; sub < 4; ++sub) usk[sub] = *(const uint2*)(ubase + (size_t)(sub * 16 + fr) * NIN + 4 * fq);
        const float Lr = lb[4096 + gp], Li = lb[6144 + gp];
        const float* er = ends_re + ((size_t)(b * SG + g) * NCH) * SP + lane; const float* ei = ends_im + ((size_t)(b * SG + g) * NCH) * SP + lane;
        for (int c2 = 0; c2 < ch; c2 += 16) { float xr[16], xi[16];
#pragma unroll
            for (int i = 0; i < 16; ++i) { const int cc = (c2 + i < ch) ? (c2 + i) : (ch - 1); xr[i] = er[cc * SP]; xi[i] = ei[cc * SP]; }
#pragma unroll
            for (int i = 0; i < 16; ++i) { const bool ok = (c2 + i < ch); const float nr = Lr * sr - Li * si + xr[i], ni = Lr * si + Li * sr + xi[i]; sr = ok ? nr : sr; si = ok ? ni : si; } }
#pragma unroll
        for (int ks = 0; ks < 4; ++ks) { const float* src = (ks < 2 ? a.c_re : a.c_im) + ((size_t)(g * 16 + fr)) * SP + 32 * (ks & 1) + 8 * fq;
            const f32x4 x0 = *(const f32x4*)src, x1 = *(const f32x4*)(src + 4); const float sg = ks < 2 ? 1.f : -1.f;
            u32x4 p; p.x = pk2(sg * x0[0], sg * x0[1]); p.y = pk2(sg * x0[2], sg * x0[3]); p.z = pk2(sg * x1[0], sg * x1[1]); p.w = pk2(sg * x1[2], sg * x1[3]);
            cf[ks] = __builtin_bit_cast(bf16x8, p); }
        dsk = *(const f32x4*)(a.d_skip + g * 16 + 4 * fq);
    }
#pragma unroll
    for (int hc = 0; hc < 2; ++hc) {
        f32x16 zero;
#pragma unroll
        for (int i = 0; i < 16; ++i) zero[i] = 0.f;
        f32x16 yr0 = MFMA32(uf[hc], bfr[0], zero), yr1 = MFMA32(uf[hc], bfr[1], zero), yi0 = MFMA32(uf[hc], bfr[2], zero), yi1 = MFMA32(uf[hc], bfr[3], zero);
#pragma unroll
        for (int i = 0; i < 16; ++i) {
            auto q = __builtin_amdgcn_permlane32_swap(__float_as_uint(yr0[i]), __float_as_uint(yr1[i]), false, false); yr0[i] = __uint_as_float(q[0]); yr1[i] = __uint_as_float(q[1]);
            auto w = __builtin_amdgcn_permlane32_swap(__float_as_uint(yi0[i]), __float_as_uint(yi1[i]), false, false); yi0[i] = __uint_as_float(w[0]); yi1[i] = __uint_as_float(w[1]); }
#pragma unroll
        for (int sub = 0; sub < 2; ++sub) {
#pragma unroll
            for (int tt = 0; tt < 16; ++tt) { const int t = sub * 16 + tt, qd = t >> 3, wv = t & 7;
                const float bur = wv < 4 ? yr0[4 * qd + wv] : yr1[4 * qd + wv - 4], bui = wv < 4 ? yi0[4 * qd + wv] : yi1[4 * qd + wv - 4];
                const float nr = lr * sr - li * si + bur, ni = lr * si + li * sr + bui; sr = nr; si = ni;
                if (PASS == 1) { Sl[tt * 136 + lane] = (unsigned short)f2bf(sr); Sl[tt * 136 + 64 + lane] = (unsigned short)f2bf(si); } }
            if (PASS == 1) {
                LDS_WAIT();
                f32x4 y = (f32x4){0.f, 0.f, 0.f, 0.f};
#pragma unroll
                for (int ks = 0; ks < 4; ++ks) { const bf16x8 af = *(const LAS bf16x8*)(Sl + fr * 136 + 32 * ks + 8 * fq);
                    y = __builtin_amdgcn_mfma_f32_16x16x32_bf16(cf[ks], af, y, 0, 0, 0); }
                const uint2 uu = usk[hc * 2 + sub];
                uint2 o; o.x = pk2(gelu_tanh(y[0] + dsk[0] * pg8::bf_lo(uu.x)), gelu_tanh(y[1] + dsk[1] * pg8::bf_hi(uu.x))); o.y = pk2(gelu_tanh(y[2] + dsk[2] * pg8::bf_lo(uu.y)), gelu_tanh(y[3] + dsk[3] * pg8::bf_hi(uu.y)));
                *(uint2*)((bf16_t*)(a.ws + WS_YSSM) + ((size_t)(b * T + ch * 64 + hc * 32 + sub * 16 + fr)) * SW + g * 16 + 4 * fq) = o;
                LDS_WAIT();
            }
        }
    }
    if (PASS == 0) { ends_re[(size_t)item * SP + lane] = sr; ends_im[(size_t)item * SP + lane] = si; }
}

__device__ __forceinline__ float row_ss(const f32x4 (&v)[4]) { float s = 0.f;
#pragma unroll
    for (int j = 0; j < 4; ++j) s += (v[j][0] * v[j][0] + v[j][1] * v[j][1]) + (v[j][2] * v[j][2] + v[j][3] * v[j][3]);
    return s; }
template <int MODE> __device__ __forceinline__ void norm_rows8(const float* xbase, bf16_t* obase, const float* gn, const float* shift, const float* scale, int lane) {
    f32x4 ca[4], cb[4];
#pragma unroll
    for (int j = 0; j < 4; ++j) { const f32x4 g = ((const f32x4*)gn)[lane + 64 * j];
        if (MODE == 0) { const f32x4 sc = ((const f32x4*)scale)[lane + 64 * j]; ca[j] = g * (sc + 1.0f); cb[j] = ((const f32x4*)shift)[lane + 64 * j]; } else { ca[j] = g; cb[j] = (f32x4){0.f, 0.f, 0.f, 0.f}; } }
#pragma unroll 1
    for (int r = 0; r < 8; r += 2) {
        const f32x4* x0 = (const f32x4*)(xbase + (size_t)r * D) + lane; const f32x4* x1 = (const f32x4*)(xbase + (size_t)(r + 1) * D) + lane;
        f32x4 v0[4], v1[4];
#pragma unroll
        for (int j = 0; j < 4; ++j) { v0[j] = x0[64 * j]; v1[j] = x1[64 * j]; }
        float s0 = row_ss(v0), s1 = row_ss(v1);
#pragma unroll
        for (int o = 1; o < 64; o <<= 1) { s0 += __shfl_xor(s0, o); s1 += __shfl_xor(s1, o); }
        const float r0 = 1.0f / sqrtf(s0 * (1.0f / D) + RMS_EPS), r1 = 1.0f / sqrtf(s1 * (1.0f / D) + RMS_EPS);
        if (MODE == 0) { uint2* o0 = (uint2*)(obase + (size_t)r * D) + lane; uint2* o1 = (uint2*)(obase + (size_t)(r + 1) * D) + lane;
#pragma unroll
            for (int j = 0; j < 4; ++j) { const f32x4 h0 = v0[j] * r0 * ca[j] + cb[j], h1 = v1[j] * r1 * ca[j] + cb[j];
                uint2 w0; w0.x = pk2(h0[0], h0[1]); w0.y = pk2(h0[2], h0[3]); o0[64 * j] = w0; uint2 w1; w1.x = pk2(h1[0], h1[1]); w1.y = pk2(h1[2], h1[3]); o1[64 * j] = w1; } }
        else { f32x4* o0 = (f32x4*)(xbase + (size_t)r * D) + lane; f32x4* o1 = (f32x4*)(xbase + (size_t)(r + 1) * D) + lane;
#pragma unroll
            for (int j = 0; j < 4; ++j) { o0[64 * j] = v0[j] * r0 * ca[j]; o1[64 * j] = v1[j] * r1 * ca[j]; } }
    }
}

__global__ void __launch_bounds__(512, 2) mega_fwd(Args a) {
    extern __shared__ __attribute__((aligned(16))) unsigned char lds_raw[];
    LAS unsigned char* lds = (LAS unsigned char*)lds_raw;
    cg::grid_group grid = cg::this_grid();
    if (a.ws == nullptr) grid.sync();
    const int tid = threadIdx.x, lane = tid & 63, wave = __builtin_amdgcn_readfirstlane(tid >> 6);
    const int Gd = gridDim.x, bx = blockIdx.x, gw = bx * 8 + wave, NGW = Gd * 8;
    unsigned char* ws = a.ws;
    { volatile LAS unsigned* st = (volatile LAS unsigned*)(lds + 131072); if (tid < 2) st[tid] = 0u; }
    __syncthreads();
    const XcdBarrier bar = xcd_barrier_post((unsigned*)(ws + WS_BAR), (volatile LAS unsigned*)(lds + 131072));
    float* mod = (float*)(ws + WS_MOD);
    bf16_t* Win_t = (bf16_t*)(ws + WS_WIN); bf16_t* Wglu_t = (bf16_t*)(ws + WS_WGLU); bf16_t* Wa_t = (bf16_t*)(ws + WS_WA); bf16_t* Wb_t = (bf16_t*)(ws + WS_WB);
    bf16_t* Wo_t = (bf16_t*)(ws + WS_WO); bf16_t* Wgu_t = (bf16_t*)(ws + WS_WGU); bf16_t* Wd_t = (bf16_t*)(ws + WS_WD);
    bf16_t* Hb = (bf16_t*)(ws + WS_H); bf16_t* proj = (bf16_t*)(ws + WS_PROJ); bf16_t* hidden = (bf16_t*)(ws + WS_PROJ);
    bf16_t* attn = (bf16_t*)(ws + WS_ATTN); bf16_t* yssm = (bf16_t*)(ws + WS_YSSM); bf16_t* s5out = (bf16_t*)(ws + WS_S5OUT);

    {
        LAS float* cond = (LAS float*)lds;
        LAS float* red = (LAS float*)(lds + 16384);
        if (bx < 192) {
            for (int i = tid; i < 4 * D; i += 512) { const float cv = a.c[i]; cond[i] = cv * __builtin_amdgcn_rcpf(1.0f + __expf(-cv)); }
            __syncthreads();
            for (int it = bx; it < 192; it += Gd) {
                const int j = it * 32 + (lane & 31), hf = lane >> 5; float acc[4] = {0.f, 0.f, 0.f, 0.f};
                const float* wp = a.w_ada + (size_t)(wave * 128 + hf) * 6144 + j; const LAS float* cp = cond + wave * 128 + hf;
#pragma unroll 16
                for (int k = 0; k < 64; ++k) { const float wv = wp[(size_t)(2 * k) * 6144];
#pragma unroll
                    for (int bb = 0; bb < 4; ++bb) acc[bb] += cp[bb * D + 2 * k] * wv; }
#pragma unroll
                for (int bb = 0; bb < 4; ++bb) { acc[bb] += __shfl_xor(acc[bb], 32); if (lane < 32) red[(wave * 4 + bb) * 32 + lane] = acc[bb]; }
                __syncthreads();
                if (tid < 128) { const int bb = tid >> 5, jj = it * 32 + (tid & 31); float sres = a.b_ada[jj];
#pragma unroll
                    for (int w = 0; w < 8; ++w) sres += red[(w * 4 + bb) * 32 + (tid & 31)];
                    mod[bb * 6144 + jj] = sres; }
                __syncthreads();
            }
        }
        { const int gp = bx * 512 + tid;
          if (gp < SG * SP) { const int g = gp >> 6;
            const float dt = expf(a.log_dt[g]), lr = a.lam_re[gp], li = a.lam_im[gp], zr = lr * dt, zi = li * dt;
            const float em = expm1f(zr), cs = cosf(zi), sn = sinf(zi), sh = sinf(0.5f * zi);
            const float m1r = em * cs - 2.0f * sh * sh, m1i = (em + 1.0f) * sn;
            const float lbr = 1.0f + m1r, lbi = m1i;
            const float inv = 1.0f / (lr * lr + li * li);
            const float cr = (m1r * lr + m1i * li) * inv, ci = (m1i * lr - m1r * li) * inv;
            float pr = lbr, pi = lbi;
#pragma unroll
            for (int k = 0; k < 6; ++k) { const float nr = pr * pr - pi * pi, ni = 2.0f * pr * pi; pr = nr; pi = ni; }
            float* lb = (float*)(ws + WS_LBAR); lb[gp] = lbr; lb[2048 + gp] = lbi; lb[4096 + gp] = pr; lb[6144 + gp] = pi;
            bf16_t* bbr = (bf16_t*)(ws + WS_BBAR) + (size_t)gp * 16; bf16_t* bbi = (bf16_t*)(ws + WS_BBAR) + 32768 + (size_t)gp * 16;
#pragma unroll
            for (int i = 0; i < 16; ++i) { const float xr = a.b_re[(size_t)gp * 16 + i], xi = a.b_im[(size_t)gp * 16 + i]; bbr[i] = (bf16_t)f2bf(cr * xr - ci * xi); bbi[i] = (bf16_t)f2bf(cr * xi + ci * xr); } } }
        LAS float* scr = (LAS float*)(lds + wave * 16384);
        constexpr int I_IN = (D / 64) * (NIN / 32), I_GLU = (SW / 64) * (SW / 32), I_A = (SW / 64) * (D / 32), I_O = (D / 64) * (D / 32), I_G = (D / 64) * (FF / 32), I_D = (FF / 64) * (D / 32);
        constexpr int NITEMS = I_IN + I_GLU + 2 * I_A + I_O + 2 * I_G + I_D;
        for (int it = gw; it < NITEMS; it += NGW) {
            int r = it;
            if (r < I_IN) { transpose_mat(a.w_in, D, NIN, Win_t, 0, r, scr, lane); continue; } r -= I_IN;
            if (r < I_GLU) { transpose_mat(a.w_glu, SW, SW, Wglu_t, 0, r, scr, lane); continue; } r -= I_GLU;
            if (r < I_A) { transpose_mat(a.w_a, SW, D, Wa_t, 0, r, scr, lane); continue; } r -= I_A;
            if (r < I_A) { transpose_mat(a.w_b, SW, D, Wb_t, 0, r, scr, lane); continue; } r -= I_A;
            if (r < I_O) { transpose_mat(a.w_o, D, D, Wo_t, 0, r, scr, lane); continue; } r -= I_O;
            if (r < I_G) { transpose_mat(a.w_gate, D, FF, Wgu_t, 1, r, scr, lane); continue; } r -= I_G;
            if (r < I_G) { transpose_mat(a.w_up, D, FF, Wgu_t, 2, r, scr, lane); continue; } r -= I_G;
            transpose_mat(a.w_down, FF, D, Wd_t, 0, r, scr, lane);
        }
    }
    xcd_barrier(bar);
    for (int m = gw * 8; m < M; m += NGW * 8) { const float* mb = mod + (size_t)(m >> 12) * 6144; norm_rows8<0>(a.x + (size_t)m * D, Hb + (size_t)m * D, a.norm1_g, mb, mb + 1024, lane); }
    xcd_barrier(bar);
    { pg8::Gemm g{Hb, Win_t, M, NIN, D}; pg8::StaticOrder S; S.init(M, NIN, Gd, bx); pg8::EpiProj E{proj};
      pg8::gemm_phase<pg8::EpiProj, pg8::StaticOrder, true, true>(lds, g, S, E); }
    xcd_barrier(bar);
    for (int it = gw; it < BATCH * 8 * (T / 32); it += NGW) attn_item(proj, attn, it, lane);
    for (int it = gw; it < BATCH * SG * NCH; it += NGW) s5_item<0>(a, it, lds + wave * 16384, lane);
    xcd_barrier(bar);
    for (int it = gw; it < BATCH * SG * NCH; it += NGW) s5_item<1>(a, it, lds + wave * 16384, lane);
    xcd_barrier(bar);
    { pg8::Gemm g{yssm, Wglu_t, M, SW, SW}; pg8::StaticOrder S; S.init(M, SW, Gd, bx); pg8::EpiGLU E{yssm, s5out, a.b_glu};
      pg8::gemm_phase<pg8::EpiGLU, pg8::StaticOrder, true, true>(lds, g, S, E); }
    xcd_barrier(bar);
    { pg8::Gemm g{s5out, Wa_t, M, D, SW}; pg8::StaticOrder S; S.init(M, D, Gd, bx); pg8::EpiMerge<false> E{proj + 2048, Hb};
      pg8::gemm_phase<pg8::EpiMerge<false>, pg8::StaticOrder, true, true>(lds, g, S, E); }
    { pg8::Gemm g{attn, Wb_t, M, D, SW}; pg8::StaticOrder S; S.init(M, D, Gd, bx); pg8::EpiMerge<true> E{proj + 3072, Hb};
      pg8::gemm_phase<pg8::EpiMerge<true>, pg8::StaticOrder, true, true>(lds, g, S, E); }
    xcd_barrier(bar);
    { pg8::Gemm g{Hb, Wo_t, M, D, D}; pg8::StaticOrder S; S.init(M, D, Gd, bx); pg8::EpiResid E{a.x, a.out, mod + 2 * 1024};
      pg8::gemm_phase<pg8::EpiResid, pg8::StaticOrder, true, true>(lds, g, S, E); }
    xcd_barrier(bar);
    for (int m = gw * 8; m < M; m += NGW * 8) { const float* mb = mod + (size_t)(m >> 12) * 6144; norm_rows8<0>(a.out + (size_t)m * D, Hb + (size_t)m * D, a.norm2_g, mb + 3 * 1024, mb + 4 * 1024, lane); }
    xcd_barrier(bar);
    { pg8::Gemm g{Hb, Wgu_t, M, 2 * FF, D}; pg8::StaticOrder S; S.init(M, 2 * FF, Gd, bx); pg8::EpiSwiGLU E{hidden};
      pg8::gemm_phase<pg8::EpiSwiGLU, pg8::StaticOrder, true, true>(lds, g, S, E); }
    xcd_barrier(bar);
    { pg8::Gemm g{hidden, Wd_t, M, D, FF}; pg8::StaticOrder S; S.init(M, D, Gd, bx); pg8::EpiResid E{a.out, a.out, mod + 5 * 1024};
      pg8::gemm_phase<pg8::EpiResid, pg8::StaticOrder, true, true>(lds, g, S, E); }
    xcd_barrier(bar);
    for (int m = gw * 8; m < M; m += NGW * 8) norm_rows8<1>(a.out + (size_t)m * D, nullptr, a.norm_f_g, nullptr, nullptr, lane);
}

extern "C" void kernel_launch(void* const* d_in, const int* in_sizes, int n_in, void* d_out, int out_size, void* d_ws, size_t ws_size, hipStream_t stream) {
    static int grid = 0;
    if (grid == 0) {
        if (n_in != 24 || ws_size < WS_END) { fprintf(stderr, "kernel_launch: unexpected inputs (n_in %d, ws %zu)\n", n_in, ws_size); grid = -1; return; }
        int dev = 0, cus = 0, per_cu = 0;
        hipGetDevice(&dev); hipDeviceGetAttribute(&cus, hipDeviceAttributeMultiprocessorCount, dev);
        if (hipFuncSetAttribute((const void*)mega_fwd, hipFuncAttributeMaxDynamicSharedMemorySize, LDS_BYTES) != hipSuccess) { fprintf(stderr, "kernel_launch: hipFuncSetAttribute failed\n"); grid = -1; return; }
        if (hipOccupancyMaxActiveBlocksPerMultiprocessor(&per_cu, (const void*)mega_fwd, 512, LDS_BYTES) != hipSuccess || per_cu < 1) { fprintf(stderr, "kernel_launch: occupancy query says %d\n", per_cu); per_cu = 1; }
        (void)hipGetLastError();
        grid = cus;
    }
    if (grid < 0) return;
    if (hipMemsetAsync((char*)d_ws + WS_BAR, 0, BAR_BYTES, stream) != hipSuccess) { fprintf(stderr, "kernel_launch: memset failed\n"); return; }
    Args a{};
    const float** ap = (const float**)&a;
    for (int i = 0; i < 24; ++i) ap[i] = (const float*)d_in[i];
    a.out = (float*)d_out; a.ws = (unsigned char*)d_ws;
    void* args[] = {&a};
    hipError_t e = hipLaunchCooperativeKernel((const void*)mega_fwd, dim3(grid), dim3(512), args, LDS_BYTES, stream);
    if (e != hipSuccess) fprintf(stderr, "cooperative launch failed: %s (grid %d)\n", hipGetErrorString(e), grid);
}
```
